# Optimizing an MI355X kernel written in HIP

```python
import math
import jax, jax.numpy as jnp
from jax import lax
import numpy as np

D_MODEL = 4096
BATCH = 32
SEQ = 256
DEPTH = 2
DEC_BATCH = 2
DEC_SEQ = 2048
PAST_LEN = 512

GRID_W = 64
HEAD_DIM = 128
N_HEADS = 16
N_KV_HEADS = 4
KV_GROUP = N_HEADS // N_KV_HEADS
ATTN_W = N_HEADS * HEAD_DIM
KV_W = N_KV_HEADS * HEAD_DIM
Q_BLOCK = 128
ATTN_SCALE = HEAD_DIM ** -0.5
ROPE_THETA = 10000.0
ROPE_PAIRS_AXIS = HEAD_DIM // 4
FNET_W = D_MODEL // 4
FNET_GROUPS = 4
FNET_GROUP_W = FNET_W // FNET_GROUPS
HYENA_W = D_MODEL // 4
HYENA_ORDER = 2
HYENA_SHORT = 3
HYENA_BANDS = 16
HYENA_POS_DIM = 1 + 2 * HYENA_BANDS
HYENA_FFN_W = 64
HYENA_MIN_DECAY = math.log(1e-2) / 0.3
HYENA_MAX_DECAY = math.log(1e-2) / 1.5
N_BRANCHES = 3
IN_SPLITS = (ATTN_W, KV_W, KV_W, ATTN_W, FNET_W, FNET_W, HYENA_W, HYENA_W, HYENA_W, HYENA_W, D_MODEL, D_MODEL, D_MODEL)
IN_W = 2 * ATTN_W + 2 * KV_W + 2 * FNET_W + 4 * HYENA_W + N_BRANCHES * D_MODEL
EPS = 1e-6

kernel_name = "hybrid_gqa_fnet_hyena_diffusion_step"


def in_offsets():
    offs, s = [], 0
    for w in IN_SPLITS[:-1]:
        s += w
        offs.append(s)
    return offs


def rms_norm(x, g):
    x32 = x.astype(jnp.float32)
    y = x32 * lax.rsqrt(jnp.mean(x32 * x32, axis=-1, keepdims=True) + EPS)
    return (y * g.astype(jnp.float32)).astype(x.dtype)


def axial_rope_tables(L):
    rows = L // GRID_W
    row = jnp.repeat(jnp.arange(rows, dtype=jnp.float32), GRID_W)
    col = jnp.tile(jnp.arange(GRID_W, dtype=jnp.float32), rows)
    inv = ROPE_THETA ** (-jnp.arange(ROPE_PAIRS_AXIS, dtype=jnp.float32) / ROPE_PAIRS_AXIS)
    ang = jnp.concatenate([row[:, None] * inv, col[:, None] * inv], axis=-1)
    return jnp.cos(ang), jnp.sin(ang)


def apply_rope(x, cos, sin):
    x32 = x.astype(jnp.float32)
    x1, x2 = x32[..., :HEAD_DIM // 2], x32[..., HEAD_DIM // 2:]
    c, s = cos[None, :, None, :], sin[None, :, None, :]
    return jnp.concatenate([x1 * c - x2 * s, x2 * c + x1 * s], axis=-1).astype(x.dtype)


def block_attention(q, k, v):
    B, L = q.shape[0], q.shape[1]
    nblk = L // Q_BLOCK
    qb = q.astype(jnp.float32).reshape(B, nblk, Q_BLOCK, N_KV_HEADS, KV_GROUP, HEAD_DIM).transpose(1, 0, 2, 3, 4, 5)
    k32, v32 = k.astype(jnp.float32), v.astype(jnp.float32)

    def one_block(qblk):
        s = jnp.einsum('bqkgd,bskd->bkgqs', qblk, k32) * ATTN_SCALE
        p = jax.nn.softmax(s, axis=-1)
        return jnp.einsum('bkgqs,bskd->bqkgd', p, v32)

    o = lax.map(one_block, qb)
    return o.transpose(1, 0, 2, 3, 4, 5).reshape(B, L, ATTN_W).astype(q.dtype)


def fourier_mix(u):
    B, L, W = u.shape
    ug = u.astype(jnp.float32).reshape(B, L, FNET_GROUPS, FNET_GROUP_W)
    f = jnp.fft.fft2(ug, axes=(1, 3), norm='ortho').real
    return f.reshape(B, L, W).astype(u.dtype)


def short_conv(u, w, b):
    L = u.shape[1]
    pad = HYENA_SHORT // 2
    up = jnp.pad(u, ((0, 0), (pad, pad), (0, 0)))
    y = b
    for j in range(HYENA_SHORT):
        y = y + up[:, j:j + L] * w[j]
    return y


def hyena_filters(L, w1, b1, w2, b2, w3, b3, freq):
    f32 = jnp.float32
    t = jnp.arange(L, dtype=f32)[:, None] / L
    bands = jnp.arange(1, HYENA_BANDS + 1, dtype=f32)[None, :]
    feats = jnp.concatenate([t, jnp.cos(2 * math.pi * t * bands), jnp.sin(2 * math.pi * t * bands)], axis=-1)
    fr = freq.astype(f32)
    h = jnp.sin(fr * (feats @ w1.astype(f32) + b1.astype(f32)))
    h = jnp.sin(fr * (h @ w2.astype(f32) + b2.astype(f32)))
    h = (h @ w3.astype(f32) + b3.astype(f32)).reshape(L, HYENA_ORDER, 2, HYENA_W)
    deltas = jnp.abs(jnp.linspace(HYENA_MIN_DECAY, HYENA_MAX_DECAY, HYENA_W, dtype=f32))
    decay = jnp.exp(-t * deltas[None, :])
    h = h * decay[:, None, None, :]
    return h / (jnp.sum(jnp.abs(h), axis=(0, 2), keepdims=True) + EPS)


def bidir_long_conv(z, h_fwd, h_bwd, bias):
    L, W = h_fwd.shape
    g = jnp.concatenate([h_fwd.at[0].add(h_bwd[0]), jnp.zeros((1, W), jnp.float32), h_bwd[:0:-1]], axis=0)
    z32 = z.astype(jnp.float32)
    y = jnp.fft.irfft(jnp.fft.rfft(z32, n=2 * L, axis=1) * jnp.fft.rfft(g, axis=0)[None], n=2 * L, axis=1)[:, :L]
    return (y + z32 * bias.astype(jnp.float32)).astype(z.dtype)


def hyena_branch(hv, hx1, hx2, short_w, short_b, filt, bias):
    u = short_conv(jnp.concatenate([hv, hx1, hx2], axis=-1), short_w, short_b)
    v, x1, x2 = jnp.split(u, 3, axis=-1)
    z = x1 * bidir_long_conv(v, filt[:, 0, 0], filt[:, 0, 1], bias[0])
    z = x2 * bidir_long_conv(z, filt[:, 1, 0], filt[:, 1, 1], bias[1])
    return z


def layer(x, cond, ctx_k, ctx_v, p):
    B, L, _ = x.shape
    dt = x.dtype
    mod = jax.nn.silu(cond.astype(jnp.float32)) @ p['w_mod'].astype(jnp.float32) + p['b_mod'].astype(jnp.float32)
    shift, scale, gate = jnp.split(mod.astype(dt)[:, None, :], 3, axis=-1)
    h = rms_norm(x, p['g_pre']) * (1 + scale) + shift
    proj = h @ p['w_in']
    q, k, v, a_gate, f_in, f_gate, hv, hx1, hx2, h_gate, g_a, g_f, g_h = jnp.split(proj, in_offsets(), axis=-1)
    q = rms_norm(q.reshape(B, L, N_HEADS, HEAD_DIM), p['q_norm'])
    k = rms_norm(k.reshape(B, L, N_KV_HEADS, HEAD_DIM), p['k_norm'])
    v = v.reshape(B, L, N_KV_HEADS, HEAD_DIM)
    if ctx_k is None:
        k_all, v_all = k, v
    else:
        cos, sin = axial_rope_tables(L)
        q = apply_rope(q, cos, sin)
        k_all = jnp.concatenate([apply_rope(k, cos, sin), ctx_k.astype(dt)], axis=1)
        v_all = jnp.concatenate([v, ctx_v.astype(dt)], axis=1)
    attn = block_attention(q, k_all, v_all) * jax.nn.silu(a_gate)
    fnet = fourier_mix(f_in) * jax.nn.silu(f_gate)
    filt = hyena_filters(L, p['hy_ffn_w1'], p['hy_ffn_b1'], p['hy_ffn_w2'], p['hy_ffn_b2'],
                         p['hy_ffn_w3'], p['hy_ffn_b3'], p['hy_sin_freq'])
    hy = hyena_branch(hv, hx1, hx2, p['hy_short_w'], p['hy_short_b'], filt, p['hy_bias']) * jax.nn.silu(h_gate)
    merged = (jax.nn.sigmoid(g_a) * (attn @ p['w_attn_o'])
              + jax.nn.sigmoid(g_f) * (fnet @ p['w_fnet_o'])
              + jax.nn.sigmoid(g_h) * (hy @ p['w_hy_o']))
    out = rms_norm(merged @ p['w_out'], p['g_post'])
    return x + gate * out, k, v


def setup_inputs(seed: int = 0) -> dict:
    key = jax.random.key(seed)
    ks = jax.random.split(key, 27)
    f32 = jnp.float32

    def nrm(k, shape, scale=1.0):
        return jax.random.normal(k, shape, f32) * scale

    return {
        'x_prompt': nrm(ks[0], (BATCH, SEQ, D_MODEL)),
        'x_sample': nrm(ks[1], (DEC_BATCH, DEC_SEQ, D_MODEL)),
        'cache_k': nrm(ks[2], (DEC_BATCH, DEPTH, PAST_LEN, N_KV_HEADS, HEAD_DIM)),
        'cache_v': nrm(ks[3], (DEC_BATCH, DEPTH, PAST_LEN, N_KV_HEADS, HEAD_DIM)),
        'c': nrm(ks[4], (DEC_BATCH, D_MODEL)),
        'c_ctx': nrm(ks[5], (D_MODEL,)),
        'w_mod': nrm(ks[6], (DEPTH, D_MODEL, 3 * D_MODEL), 0.3 * D_MODEL ** -0.5),
        'b_mod': nrm(ks[7], (DEPTH, 3 * D_MODEL), 0.01),
        'g_pre': 1.0 + nrm(ks[8], (DEPTH, D_MODEL), 0.1),
        'w_in': nrm(ks[9], (DEPTH, D_MODEL, IN_W), D_MODEL ** -0.5),
        'q_norm': 1.0 + nrm(ks[10], (DEPTH, HEAD_DIM), 0.1),
        'k_norm': 1.0 + nrm(ks[11], (DEPTH, HEAD_DIM), 0.1),
        'hy_short_w': nrm(ks[12], (DEPTH, HYENA_SHORT, 3 * HYENA_W), HYENA_SHORT ** -0.5),
        'hy_short_b': nrm(ks[13], (DEPTH, 3 * HYENA_W), 0.01),
        'hy_ffn_w1': nrm(ks[14], (DEPTH, HYENA_POS_DIM, HYENA_FFN_W), HYENA_POS_DIM ** -0.5),
        'hy_ffn_b1': nrm(ks[15], (DEPTH, HYENA_FFN_W), 0.1),
        'hy_ffn_w2': nrm(ks[16], (DEPTH, HYENA_FFN_W, HYENA_FFN_W), HYENA_FFN_W ** -0.5),
        'hy_ffn_b2': nrm(ks[17], (DEPTH, HYENA_FFN_W), 0.1),
        'hy_ffn_w3': nrm(ks[18], (DEPTH, HYENA_FFN_W, HYENA_ORDER * 2 * HYENA_W), HYENA_FFN_W ** -0.5),
        'hy_ffn_b3': nrm(ks[19], (DEPTH, HYENA_ORDER * 2 * HYENA_W), 0.01),
        'hy_sin_freq': 1.0 + nrm(ks[20], (DEPTH, HYENA_FFN_W), 0.1),
        'hy_bias': nrm(ks[21], (DEPTH, HYENA_ORDER, HYENA_W), 0.1),
        'w_attn_o': nrm(ks[22], (DEPTH, ATTN_W, D_MODEL), ATTN_W ** -0.5),
        'w_fnet_o': nrm(ks[23], (DEPTH, FNET_W, D_MODEL), FNET_W ** -0.5),
        'w_hy_o': nrm(ks[24], (DEPTH, HYENA_W, D_MODEL), HYENA_W ** -0.5),
        'w_out': nrm(ks[25], (DEPTH, D_MODEL, D_MODEL), D_MODEL ** -0.5),
        'g_post': 1.0 + nrm(ks[26], (DEPTH, D_MODEL), 0.1),
    }


def reference(x_prompt, x_sample, cache_k, cache_v, c, c_ctx, w_mod, b_mod, g_pre, w_in, q_norm, k_norm,
              hy_short_w, hy_short_b, hy_ffn_w1, hy_ffn_b1, hy_ffn_w2, hy_ffn_b2, hy_ffn_w3, hy_ffn_b3,
              hy_sin_freq, hy_bias, w_attn_o, w_fnet_o, w_hy_o, w_out, g_post):
    params = [dict(w_mod=w_mod[l], b_mod=b_mod[l], g_pre=g_pre[l], w_in=w_in[l], q_norm=q_norm[l],
                   k_norm=k_norm[l], hy_short_w=hy_short_w[l], hy_short_b=hy_short_b[l],
                   hy_ffn_w1=hy_ffn_w1[l], hy_ffn_b1=hy_ffn_b1[l], hy_ffn_w2=hy_ffn_w2[l],
                   hy_ffn_b2=hy_ffn_b2[l], hy_ffn_w3=hy_ffn_w3[l], hy_ffn_b3=hy_ffn_b3[l],
                   hy_sin_freq=hy_sin_freq[l], hy_bias=hy_bias[l], w_attn_o=w_attn_o[l],
                   w_fnet_o=w_fnet_o[l], w_hy_o=w_hy_o[l], w_out=w_out[l], g_post=g_post[l])
              for l in range(DEPTH)]

    xp = x_prompt
    ctx_cond = c_ctx[None, :]
    ks_list, vs_list = [], []
    for l in range(DEPTH):
        xp, k_l, v_l = layer(xp, ctx_cond, None, None, params[l])
        ks_list.append(k_l)
        vs_list.append(v_l)
    y_prompt = xp
    new_cache_k = jnp.stack(ks_list, axis=1)
    new_cache_v = jnp.stack(vs_list, axis=1)

    xs = x_sample
    for l in range(DEPTH):
        xs, _, _ = layer(xs, c, cache_k[:, l], cache_v[:, l], params[l])
    y_sample = xs

    return (y_prompt, y_sample, new_cache_k, new_cache_v)
```

```cpp
#include <hip/hip_runtime.h>
#include <hip/hip_bf16.h>
#include <cstdio>
#include <cstdint>

#ifndef MK_PER_PHASE
#define MK_PER_PHASE 0
#endif

constexpr int DM = 4096, M_CTX = 8192, M_LAT = 4096, MTOK = 12288;
constexpr int L_CTX = 256, L_LAT = 2048, PAST = 512, KV_LAT = 2560;
constexpr int INW = 23552;
constexpr int C_K = 2048, C_V = 2560, C_AG = 3072, C_FIN = 5120, C_FG = 6144, C_HV = 7168, C_HG = 10240, C_GA = 11264;
constexpr float EPS = 1e-6f;

constexpr size_t MiB = 1u << 20;
constexpr size_t al(size_t x) { return (x + MiB - 1) / MiB * MiB; }
constexpr size_t WS_CTL = 0, CTL_ZERO_BYTES = MiB;
constexpr size_t WS_WIN = MiB;
constexpr size_t WS_WM = WS_WIN + al((size_t)2 * INW * DM * 2);
constexpr size_t WS_WO = WS_WM + al((size_t)2 * DM * DM * 2);
constexpr size_t WS_H = WS_WO + al((size_t)2 * DM * DM * 2);
constexpr size_t WS_PROJ = WS_H + al((size_t)MTOK * DM * 2);
constexpr size_t WS_QKV = WS_PROJ + al((size_t)MTOK * INW * 2);
constexpr size_t WS_Q = WS_QKV + al((size_t)MTOK * 3072 * 4);
constexpr size_t WS_KC = WS_Q + al((size_t)MTOK * 2048 * 2);
constexpr size_t WS_VC = WS_KC + al((size_t)M_CTX * 512 * 2);
constexpr size_t WS_KL = WS_VC + al((size_t)M_CTX * 512 * 2);
constexpr size_t WS_VL = WS_KL + al((size_t)2 * KV_LAT * 512 * 2);
constexpr size_t WS_BR = WS_VL + al((size_t)2 * KV_LAT * 512 * 2);
constexpr size_t WS_UCSC = WS_BR + al((size_t)MTOK * DM * 2);
constexpr size_t WS_UCSL = WS_UCSC + al((size_t)32 * 1024 * 512 * 2);
constexpr size_t WS_U = WS_UCSL + al((size_t)2 * 1024 * 4096 * 2);
constexpr size_t WS_Z1 = WS_U + al((size_t)MTOK * 3072 * 4);
constexpr size_t WS_P = WS_Z1 + al((size_t)MTOK * 1024 * 4);
constexpr size_t WS_MG = WS_P + al((size_t)MTOK * DM * 4);
constexpr size_t WS_O = WS_MG + al((size_t)MTOK * DM * 2);
constexpr size_t WS_X1 = WS_O + al((size_t)MTOK * DM * 4);
constexpr size_t WS_MODP = WS_X1 + al((size_t)MTOK * DM * 4);
constexpr size_t WS_MOD = WS_MODP + al((size_t)2 * 32 * 3 * 12288 * 4);
constexpr size_t WS_HRAW = WS_MOD + al((size_t)2 * 3 * 12288 * 4);
constexpr size_t WS_PART = WS_HRAW + al((size_t)2 * 2304 * 4096 * 4);
constexpr size_t WS_INVN = WS_PART + al((size_t)2 * 144 * 4096 * 4);
constexpr size_t WS_TT = WS_INVN + MiB;
constexpr size_t WS_CS = WS_TT + al((size_t)2 * 9216 * 1024 * 4);
constexpr size_t WS_FL256 = WS_CS + MiB;
constexpr size_t WS_FL2048 = WS_FL256 + MiB;
constexpr size_t WS_H8 = WS_FL2048 + al((size_t)2048 * 4096 * 2);
constexpr size_t WS_WIN8 = WS_H8 + al((size_t)MTOK * DM);
constexpr int N8 = 2048 + 2048 + 4096 + 12288;
constexpr size_t WS_END = WS_WIN8 + al((size_t)2 * N8 * DM);

#define GAS __attribute__((address_space(1)))
#define LAS __attribute__((address_space(3)))
typedef unsigned short bf16_t;
typedef short bf16x8 __attribute__((ext_vector_type(8)));
typedef float f32x4 __attribute__((ext_vector_type(4)));
typedef float f32x2 __attribute__((ext_vector_type(2)));
typedef float f32x16 __attribute__((ext_vector_type(16)));
typedef unsigned u32x4 __attribute__((ext_vector_type(4)));
typedef unsigned u32x2 __attribute__((ext_vector_type(2)));
typedef short s16x4 __attribute__((ext_vector_type(4)));
#define LDS_WAIT() asm volatile("s_waitcnt lgkmcnt(0)" ::: "memory")
#define VM_WAIT() asm volatile("s_waitcnt vmcnt(0)" ::: "memory")
__device__ __forceinline__ unsigned cvt_pk_bf16(float lo, float hi) { unsigned r; asm volatile("v_cvt_pk_bf16_f32 %0, %1, %2" : "=v"(r) : "v"(lo), "v"(hi)); return r; }
__device__ __forceinline__ bf16_t f2bf(float f) { return (bf16_t)(cvt_pk_bf16(f, 0.f) & 0xffffu); }
__device__ __forceinline__ float bf2f(unsigned h) { return __uint_as_float(h << 16); }
__device__ __forceinline__ unsigned pk_fp8x4(float a, float b, float c, float d) {
    a = __builtin_amdgcn_fmed3f(a, -448.f, 448.f); b = __builtin_amdgcn_fmed3f(b, -448.f, 448.f); c = __builtin_amdgcn_fmed3f(c, -448.f, 448.f); d = __builtin_amdgcn_fmed3f(d, -448.f, 448.f);
    int w = 0; w = __builtin_amdgcn_cvt_pk_fp8_f32(a, b, w, false); w = __builtin_amdgcn_cvt_pk_fp8_f32(c, d, w, true); return (unsigned)w; }
__device__ __forceinline__ float sigmoid_f(float x) { return __builtin_amdgcn_rcpf(1.f + __builtin_amdgcn_exp2f(-1.4426950408889634f * x)); }
__device__ __forceinline__ float silu_f(float x) { return x * sigmoid_f(x); }
__device__ __forceinline__ int lane_id() { int l; asm volatile("v_mbcnt_lo_u32_b32 %0, -1, 0\n\tv_mbcnt_hi_u32_b32 %0, -1, %0" : "=v"(l)); return l; }
__device__ __forceinline__ float sum_fq4(float s) {
    { auto r = __builtin_amdgcn_permlane16_swap(__float_as_uint(s), __float_as_uint(s), false, false); s = __uint_as_float(r[0]) + __uint_as_float(r[1]); }
    { auto r = __builtin_amdgcn_permlane32_swap(__float_as_uint(s), __float_as_uint(s), false, false); s = __uint_as_float(r[0]) + __uint_as_float(r[1]); }
    return s;
}
__device__ __forceinline__ float wave_sum(float v) {
    v += __int_as_float(__builtin_amdgcn_mov_dpp(__float_as_int(v), 0xB1, 0xF, 0xF, true));
    v += __int_as_float(__builtin_amdgcn_mov_dpp(__float_as_int(v), 0x4E, 0xF, 0xF, true));
    v += __int_as_float(__builtin_amdgcn_mov_dpp(__float_as_int(v), 0x141, 0xF, 0xF, true));
    v += __int_as_float(__builtin_amdgcn_mov_dpp(__float_as_int(v), 0x140, 0xF, 0xF, true));
    return sum_fq4(v);
}

namespace pg8 {
constexpr int BM = 256, BK = 64, HALF = 128, HTB = HALF * BK * 2, STAGE_BYTES = 8 * HTB, NXCD = 8, WGM = 8;
__host__ __device__ __forceinline__ int lds_byte(int r, int c) { const int st = (r >> 4) * 2 + (c >> 5), rr = r & 15, cc = c & 31, ob = rr * 64 + cc * 2; return st * 1024 + (ob ^ (((ob >> 9) & 1) << 5)); }
__host__ __device__ __forceinline__ void stage_rc(int b, int& R, int& C) { const int st = b / 1024, sb = b % 1024, swz = sb ^ (((sb >> 9) & 1) << 5); R = (st >> 1) * 16 + swz / 64; C = (st & 1) * 32 + (swz % 64) / 2; }
__host__ __device__ __forceinline__ int perm32(int rho) { const int n = rho >> 4, i = rho & 15; return 8 * (i >> 2) + 4 * n + (i & 3); }

struct Unit { const char* a; const char* b; int K, pm, pn, aux, f8; };
struct Gemm { int lda, ldb; };

__device__ __forceinline__ void tile_of(int L, int nM, int nN, int& pm, int& pn) {
    const int nwg = nM * nN; int wgid = L;
    { const int q = nwg / NXCD, r = nwg % NXCD, xcd = wgid % NXCD, off = wgid / NXCD; wgid = (xcd < r ? xcd * (q + 1) : r * (q + 1) + (xcd - r) * q) + off; }
    const int nig = WGM * nN, gid = wgid / nig, fm = gid * WGM, gsz = (nM - fm) < WGM ? (nM - fm) : WGM;
    pm = fm + ((wgid % nig) % gsz); pn = (wgid % nig) / gsz;
}

__device__ __forceinline__ void tile_of_id(int id, int nM, int nN, int& pm, int& pn) {
    const int nig = WGM * nN, gid = id / nig, fm = gid * WGM, gsz = (nM - fm) < WGM ? (nM - fm) : WGM;
    pm = fm + ((id % nig) % gsz); pn = (id % nig) / gsz;
}
template <int PERMK = 0, int F8 = 0, class Epi, class Sched>
__device__ __forceinline__ void gemm_phase(LAS unsigned char* lds, const Gemm g, const Sched& S, const Epi& E, int wave_) {
    constexpr bool ALIGN_EPI = true;
    int lane = lane_id(); asm volatile("" : "+v"(lane));
    const int wid = wave_, tid = wave_ * 64 + lane, wr = wid >> 2, wc = wid & 3, fr = lane & 15, fq = lane >> 4;
    unsigned voffA[2], voffB[2];
#pragma unroll
    for (int i = 0; i < 2; ++i) { int R, C; stage_rc(tid * 16 + i * 8192, R, C); const int Rb = PERMK ? (64 * ((R >> 4) & 1) + 16 * ((R >> 5) & 3) + (R & 15)) : ((R & ~31) + perm32(R & 31));
        voffA[i] = (unsigned)(R * g.lda + C) * 2u; voffB[i] = (unsigned)(Rb * g.ldb + C) * 2u; }
    const size_t kstep = (size_t)(BK * 2);
    const size_t hstepA = (size_t)HALF * g.lda * 2, hstepB = (size_t)HALF * g.ldb * 2;
    const unsigned ldsw = (unsigned)wid * 1024u;
    const int aoff = lds_byte(wr * 64 + fr, fq * 8), boff = lds_byte(wc * 32 + fr, fq * 8);
#define PG8_SA(b, h) (((b) * 2 + (h)) * HTB)
#define PG8_SB(b, h) ((4 + (b) * 2 + (h)) * HTB)
#define PG8_STAGE(bufoff, gbase, voff) do { _Pragma("unroll") for (int _i = 0; _i < 2; ++_i) { \
        if constexpr (F8 != 0) { unsigned keep_; const unsigned ldst_ = (unsigned)__builtin_amdgcn_readfirstlane((int)((unsigned)(uintptr_t)(lds + (bufoff) + ldsw + _i * 8192))); \
            asm volatile("s_mov_b32 %0, m0\n\ts_mov_b32 m0, %3\n\ts_nop 0\n\tglobal_load_lds_dwordx4 %1, %2\n\ts_mov_b32 m0, %0" : "=&s"(keep_) : "v"((voff)[_i]), "s"((const char*)(gbase)), "s"(ldst_) : "memory"); } \
        else __builtin_amdgcn_global_load_lds((const unsigned*)((const char*)(gbase) + (voff)[_i]), (LAS unsigned*)(lds + (bufoff) + ldsw + _i * 8192), 16, 0, 0); } } while (0)
    typedef int v4i_ __attribute__((ext_vector_type(4))); typedef int v8i_ __attribute__((ext_vector_type(8)));
#define PG8_LDA(dst, b, h) do { _Pragma("unroll") for (int m = 0; m < 4; ++m) { if constexpr (F8 != 0) { dst##8[m].lo = *(const LAS v4i_*)(lds + PG8_SA(b, h) + aoff + m * 2048); dst##8[m].hi = *(const LAS v4i_*)(lds + PG8_SA(b, h) + aoff + m * 2048 + 1024); } \
        else { _Pragma("unroll") for (int k = 0; k < 2; ++k) dst[m][k] = *(const LAS bf16x8*)(lds + PG8_SA(b, h) + aoff + m * 2048 + k * 1024); } } } while (0)
#define PG8_LDB(dst, b, h) do { _Pragma("unroll") for (int n = 0; n < 2; ++n) { if constexpr (F8 != 0) { dst##8[n].lo = *(const LAS v4i_*)(lds + PG8_SB(b, h) + boff + n * 2048); dst##8[n].hi = *(const LAS v4i_*)(lds + PG8_SB(b, h) + boff + n * 2048 + 1024); } \
        else { _Pragma("unroll") for (int k = 0; k < 2; ++k) dst[n][k] = *(const LAS bf16x8*)(lds + PG8_SB(b, h) + boff + n * 2048 + k * 1024); } } } while (0)
#define PG8_MMA8(ai, bj, At, Bt) do { __builtin_amdgcn_s_setprio(1); _Pragma("unroll") for (int m = 0; m < 4; ++m) _Pragma("unroll") for (int n = 0; n < 2; ++n) { \
        asm volatile("v_mfma_scale_f32_16x16x128_f8f6f4 %0, %1, %2, %0, %3, %4 op_sel_hi:[0,0,0]" : "+v"(acc[ai][bj][m][n]) : "v"(Bt##8[n]), "v"(At##8[m]), "v"(sclB_), "v"(sclA_)); } \
        __builtin_amdgcn_s_setprio(0); } while (0)
#define PG8_MMA16(ai, bj, At, Bt) do { __builtin_amdgcn_s_setprio(1); \
        if constexpr (F8 != 0) { \
            _Pragma("unroll") for (int m = 0; m < 4; ++m) _Pragma("unroll") for (int n = 0; n < 2; ++n) asm volatile("v_mfma_f32_16x16x32_bf16 %0, %1, %2, %0" : "+v"(acc[ai][bj][m][n]) : "v"(Bt##8[n].lo), "v"(At##8[m].lo)); \
            _Pragma("unroll") for (int m = 0; m < 4; ++m) _Pragma("unroll") for (int n = 0; n < 2; ++n) asm volatile("v_mfma_f32_16x16x32_bf16 %0, %1, %2, %0" : "+v"(acc[ai][bj][m][n]) : "v"(Bt##8[n].hi), "v"(At##8[m].hi)); } \
        else { _Pragma("unroll") for (int m = 0; m < 4; ++m) _Pragma("unroll") for (int n = 0; n < 2; ++n) { _Pragma("unroll") for (int k = 0; k < 2; ++k) acc[ai][bj][m][n] = __builtin_amdgcn_mfma_f32_16x16x32_bf16(Bt[n][k], At[m][k], acc[ai][bj][m][n], 0, 0, 0); } } \
        __builtin_amdgcn_s_setprio(0); } while (0)
#define PG8_WAIT_V(n) asm volatile("s_waitcnt vmcnt(" #n ")" ::: "memory")
#define PG8_WAIT_L(n) asm volatile("s_waitcnt lgkmcnt(" #n ")" ::: "memory")
#define PG8_BAR __builtin_amdgcn_s_barrier()
#define PG8_SCHED __builtin_amdgcn_sched_barrier(0)
    Unit cur, nxt; int ui = 0;
    const bool leader_ = (wid == 0) && (lane == 0);
    if constexpr (Sched::DYN) { if (leader_) { unsigned qc = S.x0; const unsigned o0 = S.draw(qc); const unsigned i0 = S.resolve(o0, qc, qc); const unsigned o1 = S.draw(qc); const unsigned i1 = S.resolve(o1, qc, qc); S.qs[0] = i0; S.qs[1] = i1; S.qs[2] = qc; }
        asm volatile("s_waitcnt vmcnt(0) lgkmcnt(0)" ::: "memory"); __builtin_amdgcn_s_barrier(); asm volatile("" ::: "memory"); }
    if (!S.next(0, cur)) return;
    f32x4 acc[2][2][4][2];
#pragma unroll
    for (int a = 0; a < 2; ++a)
#pragma unroll
        for (int b = 0; b < 2; ++b)
#pragma unroll
            for (int m = 0; m < 4; ++m)
#pragma unroll
                for (int n = 0; n < 2; ++n) acc[a][b][m][n] = (f32x4){0.f, 0.f, 0.f, 0.f};
    bf16x8 At[4][2], B0[2][2], B1[2][2]; v8i_ At8[4], B08[2], B18[2];
    int sclB_ = 0x79797979, sclA_ = (F8 == 2) ? 0x79797979 : 0x7f7f7f7f; if constexpr (F8 != 0) asm volatile("" : "+v"(sclB_), "+v"(sclA_));
    const char* cA = cur.a; const char* cB = cur.b;
    PG8_STAGE(PG8_SB(0, 0), cB, voffB); PG8_STAGE(PG8_SB(0, 1), cB + hstepB, voffB); PG8_STAGE(PG8_SA(0, 0), cA, voffA); PG8_STAGE(PG8_SA(0, 1), cA + hstepA, voffA);
    if (wr == 1) PG8_BAR;
    PG8_WAIT_V(2); PG8_BAR;
    PG8_STAGE(PG8_SB(1, 0), cB + kstep, voffB); PG8_STAGE(PG8_SA(1, 0), cA + kstep, voffA); PG8_STAGE(PG8_SB(1, 1), cB + hstepB + kstep, voffB);
    PG8_WAIT_V(6); PG8_BAR;
    for (;;) {
        const bool has_next = S.next(ui + 1, nxt);
        const char* nA = has_next ? nxt.a : cA; const char* nB = has_next ? nxt.b : cB;
        const int nt = cur.K / BK;
#define PG8_KLOOP(MMA) _Pragma("nounroll") for (int t = 0; t < nt; t += 2) { \
            unsigned pend_ = 0u; \
            if constexpr (Sched::DYN) { if (t == 2 && leader_) { unsigned* ap_ = S.ctr0 + S.qs[2] * 64; unsigned one_ = 1u; \
                    asm volatile("global_atomic_add %0, %1, %2, off sc0" : "=v"(pend_) : "v"(ap_), "v"(one_) : "memory"); } } \
            const bool last = (t == nt - 2); \
            const char* a1 = cA + (size_t)(t + 1) * kstep; \
            const char* a2 = last ? nA : cA + (size_t)(t + 2) * kstep; const char* b2 = last ? nB : cB + (size_t)(t + 2) * kstep; \
            const char* a3 = a2 + kstep; const char* b3 = b2 + kstep; \
            PG8_LDB(B0, 0, 0); PG8_LDB(B1, 0, 1); PG8_SCHED; PG8_LDA(At, 0, 0); PG8_STAGE(PG8_SA(1, 1), a1 + hstepA, voffA); \
            PG8_WAIT_V(8); PG8_WAIT_L(0); PG8_BAR; MMA(0, 0, At, B0); MMA(0, 1, At, B1); PG8_BAR; PG8_SCHED; \
            PG8_LDA(At, 0, 1); PG8_STAGE(PG8_SB(0, 0), b2, voffB); PG8_STAGE(PG8_SB(0, 1), b2 + hstepB, voffB); PG8_STAGE(PG8_SA(0, 0), a2, voffA); \
            PG8_WAIT_V(8); PG8_WAIT_L(0); PG8_BAR; MMA(1, 0, At, B0); MMA(1, 1, At, B1); PG8_BAR; PG8_SCHED; \
            PG8_LDB(B0, 1, 0); PG8_LDB(B1, 1, 1); PG8_SCHED; PG8_LDA(At, 1, 0); PG8_STAGE(PG8_SA(0, 1), a2 + hstepA, voffA); \
            PG8_WAIT_V(8); PG8_WAIT_L(0); PG8_BAR; MMA(0, 0, At, B0); MMA(0, 1, At, B1); PG8_BAR; PG8_SCHED; \
            PG8_LDA(At, 1, 1); PG8_STAGE(PG8_SB(1, 0), b3, voffB); PG8_STAGE(PG8_SB(1, 1), b3 + hstepB, voffB); PG8_STAGE(PG8_SA(1, 0), a3, voffA); \
            PG8_WAIT_V(8); PG8_WAIT_L(0); PG8_BAR; MMA(1, 0, At, B0); MMA(1, 1, At, B1); PG8_BAR; PG8_SCHED; \
            if constexpr (Sched::DYN) { if (t == 2 && leader_) { asm volatile("s_waitcnt vmcnt(8)" : "+v"(pend_) :: "memory"); \
                    unsigned qc = S.qs[2]; const unsigned id_ = S.resolve(pend_, qc, qc); S.qs[ui & 1] = id_; S.qs[2] = qc; } } \
        }
#define PG8_MMAX(ai, bj, At, Bt) do { __builtin_amdgcn_s_setprio(1); asm volatile( \
            "s_cmp_eq_u32 %[f], 0\n\ts_cbranch_scc1 1f\n\t" \
            "v_mfma_scale_f32_16x16x128_f8f6f4 %0, %[b0], %[a0], %0, %[sb], %[sa] op_sel_hi:[0,0,0]\n\t" \
            "v_mfma_scale_f32_16x16x128_f8f6f4 %1, %[b1], %[a0], %1, %[sb], %[sa] op_sel_hi:[0,0,0]\n\t" \
            "v_mfma_scale_f32_16x16x128_f8f6f4 %2, %[b0], %[a1], %2, %[sb], %[sa] op_sel_hi:[0,0,0]\n\t" \
            "v_mfma_scale_f32_16x16x128_f8f6f4 %3, %[b1], %[a1], %3, %[sb], %[sa] op_sel_hi:[0,0,0]\n\t" \
            "v_mfma_scale_f32_16x16x128_f8f6f4 %4, %[b0], %[a2], %4, %[sb], %[sa] op_sel_hi:[0,0,0]\n\t" \
            "v_mfma_scale_f32_16x16x128_f8f6f4 %5, %[b1], %[a2], %5, %[sb], %[sa] op_sel_hi:[0,0,0]\n\t" \
            "v_mfma_scale_f32_16x16x128_f8f6f4 %6, %[b0], %[a3], %6, %[sb], %[sa] op_sel_hi:[0,0,0]\n\t" \
            "v_mfma_scale_f32_16x16x128_f8f6f4 %7, %[b1], %[a3], %7, %[sb], %[sa] op_sel_hi:[0,0,0]\n\t" \
            "s_branch 2f\n1:\n\t" \
            "v_mfma_f32_16x16x32_bf16 %0, %[b0l], %[a0l], %0\n\t" \
            "v_mfma_f32_16x16x32_bf16 %1, %[b1l], %[a0l], %1\n\t" \
            "v_mfma_f32_16x16x32_bf16 %2, %[b0l], %[a1l], %2\n\t" \
            "v_mfma_f32_16x16x32_bf16 %3, %[b1l], %[a1l], %3\n\t" \
            "v_mfma_f32_16x16x32_bf16 %4, %[b0l], %[a2l], %4\n\t" \
            "v_mfma_f32_16x16x32_bf16 %5, %[b1l], %[a2l], %5\n\t" \
            "v_mfma_f32_16x16x32_bf16 %6, %[b0l], %[a3l], %6\n\t" \
            "v_mfma_f32_16x16x32_bf16 %7, %[b1l], %[a3l], %7\n\t" \
            "v_mfma_f32_16x16x32_bf16 %0, %[b0h], %[a0h], %0\n\t" \
            "v_mfma_f32_16x16x32_bf16 %1, %[b1h], %[a0h], %1\n\t" \
            "v_mfma_f32_16x16x32_bf16 %2, %[b0h], %[a1h], %2\n\t" \
            "v_mfma_f32_16x16x32_bf16 %3, %[b1h], %[a1h], %3\n\t" \
            "v_mfma_f32_16x16x32_bf16 %4, %[b0h], %[a2h], %4\n\t" \
            "v_mfma_f32_16x16x32_bf16 %5, %[b1h], %[a2h], %5\n\t" \
            "v_mfma_f32_16x16x32_bf16 %6, %[b0h], %[a3h], %6\n\t" \
            "v_mfma_f32_16x16x32_bf16 %7, %[b1h], %[a3h], %7\n\t" \
            "2:" \
            : "+v"(acc[ai][bj][0][0]), "+v"(acc[ai][bj][0][1]), "+v"(acc[ai][bj][1][0]), "+v"(acc[ai][bj][1][1]), "+v"(acc[ai][bj][2][0]), "+v"(acc[ai][bj][2][1]), "+v"(acc[ai][bj][3][0]), "+v"(acc[ai][bj][3][1]) \
            : [a0] "v"(At##8[0]), [a1] "v"(At##8[1]), [a2] "v"(At##8[2]), [a3] "v"(At##8[3]), [b0] "v"(Bt##8[0]), [b1] "v"(Bt##8[1]), [a0l] "v"(At##8[0].lo), [a0h] "v"(At##8[0].hi), [a1l] "v"(At##8[1].lo), [a1h] "v"(At##8[1].hi), [a2l] "v"(At##8[2].lo), [a2h] "v"(At##8[2].hi), [a3l] "v"(At##8[3].lo), [a3h] "v"(At##8[3].hi), [b0l] "v"(Bt##8[0].lo), [b0h] "v"(Bt##8[0].hi), [b1l] "v"(Bt##8[1].lo), [b1h] "v"(Bt##8[1].hi), [sb] "v"(sclB_), [sa] "v"(sclA_), [f] "s"(f8u_) \
            : "scc"); __builtin_amdgcn_s_setprio(0); } while (0)
        if constexpr (F8 == 2) { const int f8u_ = __builtin_amdgcn_readfirstlane(cur.f8); PG8_KLOOP(PG8_MMAX) }
        else if constexpr (F8 == 1) { PG8_KLOOP(PG8_MMA8) }
        else { PG8_KLOOP(PG8_MMA16) }
        if constexpr (ALIGN_EPI) { if (wr == 0) PG8_BAR; }
        if constexpr (F8 != 0) asm volatile("s_nop 15\n\ts_nop 15\n\ts_nop 7" ::: "memory");
        int fr_ = fr, fq_ = fq; asm volatile("" : "+v"(fr_), "+v"(fq_));
        Unit cu_ = cur; asm volatile("" : "+s"(cu_.pm), "+s"(cu_.pn), "+s"(cu_.aux));
        const bool keep = E(acc, cu_, wr, wc, fr_, fq_);
        if (!has_next) break;
        if (!keep) {
#pragma unroll
        for (int a = 0; a < 2; ++a)
#pragma unroll
            for (int b = 0; b < 2; ++b)
#pragma unroll
                for (int m = 0; m < 4; ++m)
#pragma unroll
                    for (int n = 0; n < 2; ++n) acc[a][b][m][n] = (f32x4){0.f, 0.f, 0.f, 0.f};
        }
        cur = nxt; cA = nA; cB = nB; ++ui;
        if constexpr (ALIGN_EPI) { if (wr == 1) PG8_BAR; }
    }
    PG8_WAIT_V(0);
    if constexpr (!ALIGN_EPI) { if (wr == 0) PG8_BAR; }
    PG8_BAR;
#undef PG8_SA
#undef PG8_SB
#undef PG8_STAGE
#undef PG8_LDA
#undef PG8_LDB
#undef PG8_MMA8
#undef PG8_MMA16
#undef PG8_KLOOP
#undef PG8_MMAX
#undef PG8_WAIT_V
#undef PG8_WAIT_L
#undef PG8_BAR
#undef PG8_SCHED
}

#define EPI_PIN(p) asm volatile("" : "+v"(p) :: "memory")
#define EPI_ADDR4(pa, ptr, stride_bytes, hf) do { const GAS char* lp_ = (ptr) + (size_t)(hf) * 128 * (stride_bytes); _Pragma("unroll") for (int m = 0; m < 4; ++m) { pa[m] = lp_; lp_ += (size_t)16 * (stride_bytes); asm volatile("" : "+v"(lp_)); } } while (0)
#define EPI_ALOAD8_NOWAIT(arr, pa) asm volatile("global_load_dwordx4 %0, %8, off\n\tglobal_load_dwordx4 %1, %8, off offset:256\n\tglobal_load_dwordx4 %2, %9, off\n\tglobal_load_dwordx4 %3, %9, off offset:256\n\t" \
        "global_load_dwordx4 %4, %10, off\n\tglobal_load_dwordx4 %5, %10, off offset:256\n\tglobal_load_dwordx4 %6, %11, off\n\tglobal_load_dwordx4 %7, %11, off offset:256" \
        : "=&v"(arr[0][0]), "=&v"(arr[0][1]), "=&v"(arr[1][0]), "=&v"(arr[1][1]), "=&v"(arr[2][0]), "=&v"(arr[2][1]), "=&v"(arr[3][0]), "=&v"(arr[3][1]) : "v"(pa[0]), "v"(pa[1]), "v"(pa[2]), "v"(pa[3]) : "memory")
#define EPI_ALOAD8_WAIT(arr, pa, keep) asm volatile("global_load_dwordx4 %0, %16, off\n\tglobal_load_dwordx4 %1, %16, off offset:256\n\tglobal_load_dwordx4 %2, %17, off\n\tglobal_load_dwordx4 %3, %17, off offset:256\n\t" \
        "global_load_dwordx4 %4, %18, off\n\tglobal_load_dwordx4 %5, %18, off offset:256\n\tglobal_load_dwordx4 %6, %19, off\n\tglobal_load_dwordx4 %7, %19, off offset:256\n\ts_waitcnt vmcnt(0)" \
        : "=&v"(arr[0][0]), "=&v"(arr[0][1]), "=&v"(arr[1][0]), "=&v"(arr[1][1]), "=&v"(arr[2][0]), "=&v"(arr[2][1]), "=&v"(arr[3][0]), "=&v"(arr[3][1]), \
          "+v"(keep[0][0]), "+v"(keep[0][1]), "+v"(keep[1][0]), "+v"(keep[1][1]), "+v"(keep[2][0]), "+v"(keep[2][1]), "+v"(keep[3][0]), "+v"(keep[3][1]) : "v"(pa[0]), "v"(pa[1]), "v"(pa[2]), "v"(pa[3]) : "memory")
#define EPI_ALOAD8H_NOWAIT(arr, pa) asm volatile("global_load_dwordx2 %0, %8, off\n\tglobal_load_dwordx2 %1, %8, off offset:128\n\tglobal_load_dwordx2 %2, %9, off\n\tglobal_load_dwordx2 %3, %9, off offset:128\n\t" \
        "global_load_dwordx2 %4, %10, off\n\tglobal_load_dwordx2 %5, %10, off offset:128\n\tglobal_load_dwordx2 %6, %11, off\n\tglobal_load_dwordx2 %7, %11, off offset:128" \
        : "=&v"(arr[0][0]), "=&v"(arr[0][1]), "=&v"(arr[1][0]), "=&v"(arr[1][1]), "=&v"(arr[2][0]), "=&v"(arr[2][1]), "=&v"(arr[3][0]), "=&v"(arr[3][1]) : "v"(pa[0]), "v"(pa[1]), "v"(pa[2]), "v"(pa[3]) : "memory")
#define EPI_ALOAD8H_WAIT(arr, pa, keep) asm volatile("global_load_dwordx2 %0, %16, off\n\tglobal_load_dwordx2 %1, %16, off offset:128\n\tglobal_load_dwordx2 %2, %17, off\n\tglobal_load_dwordx2 %3, %17, off offset:128\n\t" \
        "global_load_dwordx2 %4, %18, off\n\tglobal_load_dwordx2 %5, %18, off offset:128\n\tglobal_load_dwordx2 %6, %19, off\n\tglobal_load_dwordx2 %7, %19, off offset:128\n\ts_waitcnt vmcnt(0)" \
        : "=&v"(arr[0][0]), "=&v"(arr[0][1]), "=&v"(arr[1][0]), "=&v"(arr[1][1]), "=&v"(arr[2][0]), "=&v"(arr[2][1]), "=&v"(arr[3][0]), "=&v"(arr[3][1]), \
          "+v"(keep[0][0]), "+v"(keep[0][1]), "+v"(keep[1][0]), "+v"(keep[1][1]), "+v"(keep[2][0]), "+v"(keep[2][1]), "+v"(keep[3][0]), "+v"(keep[3][1]) : "v"(pa[0]), "v"(pa[1]), "v"(pa[2]), "v"(pa[3]) : "memory")
#define EPI_LOAD16(arr, ptr, stride_bytes, AI0, AI1) do { const GAS char* lp_ = (ptr); \
    _Pragma("unroll") for (int ai = 0; ai < 2; ++ai) _Pragma("unroll") for (int m = 0; m < 4; ++m) { \
        if (ai >= (AI0) && ai < (AI1)) { _Pragma("unroll") for (int bj = 0; bj < 2; ++bj) arr[(ai - (AI0)) * 4 + m][bj] = *(const GAS u32x4*)(lp_ + bj * 256); } \
        lp_ += (size_t)((m == 3) ? 80 : 16) * (stride_bytes); asm volatile("" : "+v"(lp_)); } } while (0)
#define EPI_ROWS(...) \
    _Pragma("unroll") for (int ai = 0; ai < 2; ++ai) _Pragma("unroll") for (int m = 0; m < 4; ++m) { \
    _Pragma("unroll") for (int bj = 0; bj < 2; ++bj) { f32x4 v0 = acc[ai][bj][m][0], v1 = acc[ai][bj][m][1]; __VA_ARGS__ } \
    const int adv = (m == 3) ? 80 : 16;
#define EPI_END }

__device__ __forceinline__ u32x4 pack8(f32x4 v0, f32x4 v1) { u32x4 w; w.x = cvt_pk_bf16(v0[0], v0[1]); w.y = cvt_pk_bf16(v0[2], v0[3]); w.z = cvt_pk_bf16(v1[0], v1[1]); w.w = cvt_pk_bf16(v1[2], v1[3]); return w; }
__device__ __forceinline__ void unpack8f8(u32x2 w, f32x4& a, f32x4& b) {
    const auto a0 = __builtin_amdgcn_cvt_pk_f32_fp8((int)w.x, false), a1 = __builtin_amdgcn_cvt_pk_f32_fp8((int)w.x, true), b0 = __builtin_amdgcn_cvt_pk_f32_fp8((int)w.y, false), b1 = __builtin_amdgcn_cvt_pk_f32_fp8((int)w.y, true);
    a = (f32x4){a0[0], a0[1], a1[0], a1[1]}; b = (f32x4){b0[0], b0[1], b1[0], b1[1]}; }
__device__ __forceinline__ void unpack8(u32x4 w, f32x4& a, f32x4& b) { a = (f32x4){bf2f(w.x & 0xffffu), bf2f(w.x >> 16), bf2f(w.y & 0xffffu), bf2f(w.y >> 16)}; b = (f32x4){bf2f(w.z & 0xffffu), bf2f(w.z >> 16), bf2f(w.w & 0xffffu), bf2f(w.w >> 16)}; }

struct EpiProj {
    bf16_t* proj; bf16_t* Qp; bf16_t* KCp; bf16_t* VCp; bf16_t* KLp; bf16_t* VLp; bf16_t* URC; bf16_t* URL; float* outk; float* outv;
    LAS float* xch; int l;
    __device__ __forceinline__ bool operator()(f32x4 (&acc)[2][2][4][2], const Unit& u, int wr, int wc, int fr, int fq) const {
        const int pn = u.pn, pm = u.pm; const int cl = 16 * wc + 4 * fq;
        if (pn >= 28 && pn < 40) {
            const int chl = (pn - 28) * 256 + wr * 64 + fr; const bool ctx = pm < 32; const int q = pm - 32;
            const int L = ctx ? L_CTX : L_LAT, nseq = ctx ? 32 : 2, sq = ctx ? pm : (q >> 3), pos0 = ctx ? 0 : (q & 7) * 256;
            bf16_t* base = ctx ? URC : URL;
            const int comp = ((pn - 28) * 256) >> 10; const int ch = chl & 1023;
            GAS char* p = (GAS char*)(base + (((size_t)comp * nseq + sq) * 1024 + ch) * L + pos0 + cl);
            EPI_ROWS({ u32x2 w0; w0.x = cvt_pk_bf16(v0[0], v0[1]); w0.y = cvt_pk_bf16(v0[2], v0[3]); u32x2 w1; w1.x = cvt_pk_bf16(v1[0], v1[1]); w1.y = cvt_pk_bf16(v1[2], v1[3]);
                       *(GAS u32x2*)(p + bj * 256) = w0; *(GAS u32x2*)(p + bj * 256 + 128) = w1; }) p += (size_t)adv * L * 2; EPI_PIN(p); EPI_END
            return false;
        }
        const size_t row = (size_t)pm * BM + wr * 64 + fr;
        if (pn >= 12) {
            const float msk = (pn >= 20 && pn < 24) ? 0.f : 1.f;
            GAS char* p = (GAS char*)(proj + row * INW + pn * BM + cl);
            EPI_ROWS({ _Pragma("unroll") for (int e = 0; e < 4; ++e) { v0[e] *= fmaf(sigmoid_f(v0[e]), msk, 1.f - msk); v1[e] *= fmaf(sigmoid_f(v1[e]), msk, 1.f - msk); }
                       u32x2 w0; w0.x = cvt_pk_bf16(v0[0], v0[1]); w0.y = cvt_pk_bf16(v0[2], v0[3]); u32x2 w1; w1.x = cvt_pk_bf16(v1[0], v1[1]); w1.y = cvt_pk_bf16(v1[2], v1[3]);
                       *(GAS u32x2*)(p + bj * 256) = w0; *(GAS u32x2*)(p + bj * 256 + 128) = w1; }) p += (size_t)adv * INW * 2; EPI_PIN(p); EPI_END
            return false;
        }
        const bool lat = pm >= 32; const int ql = pm - 32; const int sq = lat ? (ql >> 3) : pm; const int pos = (lat ? (ql & 7) * 256 : 0) + wr * 64 + fr;
        if (pn < 10) {
            const int rl = wr * 64 + fr;
            { LAS float* xp = xch + rl * 8 + wc;
              EPI_ROWS({ float s_ = (v0[0] * v0[0] + v0[1] * v0[1]) + (v0[2] * v0[2] + v0[3] * v0[3]) + (v1[0] * v1[0] + v1[1] * v1[1]) + (v1[2] * v1[2] + v1[3] * v1[3]);
                         s_ = sum_fq4(s_); if (fq == 0) xp[bj * 4] = s_; }) xp += adv * 8; EPI_END }
            asm volatile("s_waitcnt lgkmcnt(0)" ::: "memory"); __builtin_amdgcn_s_barrier(); asm volatile("" ::: "memory");
            const LAS float* gv = xch + 2048 + ((pn < 8) ? 0 : 128); const f32x4 g0 = *(const LAS f32x4*)(gv + cl), g1 = *(const LAS f32x4*)(gv + 64 + cl);
            f32x4 cst[4], snt[4];
            if (lat) { f32x4 inv; _Pragma("unroll") for (int e = 0; e < 4; ++e) inv[e] = __builtin_amdgcn_exp2f(-(float)((cl + e) & 31) * 0.41524101186092029f);
                _Pragma("unroll") for (int k = 0; k < 4; ++k) { const float bs = (wc < 2) ? (float)(4 * (ql & 7) + 2 * k + wr) : (float)(16 * k + fr);
                    _Pragma("unroll") for (int e = 0; e < 4; ++e) { const float rv = bs * inv[e] * 0.15915494309189535f; cst[k][e] = __builtin_amdgcn_cosf(rv); snt[k][e] = __builtin_amdgcn_sinf(rv); } } }
            const LAS float* xq = xch + rl * 8;
            if (pn < 8) {
                GAS char* p = (GAS char*)Qp + row * 2048 + pn * BM + cl;
                EPI_ROWS({ const f32x4 t4 = *(const LAS f32x4*)(xq + bj * 4); const float rs = 1.0f / sqrtf(((t4[0] + t4[1]) + (t4[2] + t4[3])) * (1.f / 128.f) + EPS);
                           f32x4 y0 = v0 * rs * g0, y1 = v1 * rs * g1;
                           if (lat) { const f32x4 cs = (wc < 2) ? cst[ai] : cst[m], sn = (wc < 2) ? snt[ai] : snt[m]; const f32x4 r0 = y0 * cs - y1 * sn, r1 = y1 * cs + y0 * sn; y0 = r0; y1 = r1; }
                           *(GAS unsigned*)(p + bj * 128) = pk_fp8x4(y0[0], y0[1], y0[2], y0[3]); *(GAS unsigned*)(p + bj * 128 + 64) = pk_fp8x4(y1[0], y1[1], y1[2], y1[3]); })
                    p += (size_t)adv * 2048; xq += adv * 8; EPI_PIN(p); EPI_END
            } else {
                const int hc = (pn - 8) * BM + cl;
                GAS char* p = (GAS char*)((lat ? KLp + ((size_t)sq * KV_LAT + pos) * 512 : KCp + row * 512) + hc);
                GAS char* po = (GAS char*)(outk + ((size_t)(sq * 2 + l) * 256 + (lat ? 0 : pos)) * 512 + hc);
                EPI_ROWS({ const f32x4 t4 = *(const LAS f32x4*)(xq + bj * 4); const float rs = 1.0f / sqrtf(((t4[0] + t4[1]) + (t4[2] + t4[3])) * (1.f / 128.f) + EPS);
                           f32x4 y0 = v0 * rs * g0, y1 = v1 * rs * g1;
                           if (!lat) { *(GAS f32x4*)(po + bj * 512) = y0; *(GAS f32x4*)(po + bj * 512 + 256) = y1; }
                           else { const f32x4 cs = (wc < 2) ? cst[ai] : cst[m], sn = (wc < 2) ? snt[ai] : snt[m]; const f32x4 r0 = y0 * cs - y1 * sn, r1 = y1 * cs + y0 * sn; y0 = r0; y1 = r1; }
                           u32x2 w0; w0.x = cvt_pk_bf16(y0[0], y0[1]); w0.y = cvt_pk_bf16(y0[2], y0[3]); u32x2 w1; w1.x = cvt_pk_bf16(y1[0], y1[1]); w1.y = cvt_pk_bf16(y1[2], y1[3]);
                           *(GAS u32x2*)(p + bj * 256) = w0; *(GAS u32x2*)(p + bj * 256 + 128) = w1; })
                    p += (size_t)adv * 512 * 2; po += (size_t)adv * 512 * 4; xq += adv * 8; EPI_PIN(p); EPI_PIN(po); EPI_END
            }
        } else {
            const int hc = (pn - 10) * BM + cl;
            GAS char* p = (GAS char*)((lat ? VLp + ((size_t)sq * KV_LAT + pos) * 512 : VCp + row * 512) + hc);
            GAS char* po = (GAS char*)(outv + ((size_t)(sq * 2 + l) * 256 + (lat ? 0 : pos)) * 512 + hc);
            EPI_ROWS({ if (!lat) { *(GAS f32x4*)(po + bj * 512) = v0; *(GAS f32x4*)(po + bj * 512 + 256) = v1; }
                       u32x2 w0; w0.x = cvt_pk_bf16(v0[0], v0[1]); w0.y = cvt_pk_bf16(v0[2], v0[3]); u32x2 w1; w1.x = cvt_pk_bf16(v1[0], v1[1]); w1.y = cvt_pk_bf16(v1[2], v1[3]);
                       *(GAS u32x2*)(p + bj * 256) = w0; *(GAS u32x2*)(p + bj * 256 + 128) = w1; })
                p += (size_t)adv * 512 * 2; po += (size_t)adv * 512 * 4; EPI_PIN(p); EPI_PIN(po); EPI_END
        }
        return false;
    }
};
struct EpiRest {
    bf16_t* proj; bf16_t* VCp; bf16_t* VLp; bf16_t* URC; bf16_t* URL; float* outv; int l;
    __device__ __forceinline__ bool in_place(const Unit& u) const { return (void)u, false; }
    __device__ __forceinline__ bool operator()(f32x4 (&acc)[2][2][4][2], const Unit& u, int wr, int wc, int fr, int fq) const {
        const int pn = u.pn, pm = u.pm; const int cw = 32 * wc + 8 * fq;
        if (pn >= 28 && pn < 40) {
            const int chl = (pn - 28) * 256 + wr * 64 + fr; const bool ctx = pm < 32; const int q = pm - 32;
            const int L = ctx ? L_CTX : L_LAT, nseq = ctx ? 32 : 2, sq = ctx ? pm : (q >> 3), pos0 = ctx ? 0 : (q & 7) * 256;
            bf16_t* base = ctx ? URC : URL; const int comp = ((pn - 28) * 256) >> 10; const int ch = chl & 1023;
            GAS char* p = (GAS char*)(base + (((size_t)comp * nseq + sq) * 1024 + ch) * L + pos0 + cw);
            EPI_ROWS({ *(GAS u32x4*)(p + bj * 256) = pack8(v0, v1); }) p += (size_t)adv * L * 2; EPI_PIN(p); EPI_END
            return false;
        }
        const size_t row = (size_t)pm * BM + wr * 64 + fr;
        if (pn >= 12) {
            const float msk = (pn >= 20 && pn < 24) ? 0.f : 1.f;
            GAS char* p = (GAS char*)(proj + row * INW + pn * BM + cw);
            EPI_ROWS({ _Pragma("unroll") for (int e = 0; e < 4; ++e) { v0[e] *= fmaf(sigmoid_f(v0[e]), msk, 1.f - msk); v1[e] *= fmaf(sigmoid_f(v1[e]), msk, 1.f - msk); }
                       *(GAS u32x4*)(p + bj * 256) = pack8(v0, v1); }) p += (size_t)adv * INW * 2; EPI_PIN(p); EPI_END
            return false;
        }
        const bool lat = pm >= 32; const int ql = pm - 32; const int sq = lat ? (ql >> 3) : pm; const int pos = (lat ? (ql & 7) * 256 : 0) + wr * 64 + fr;
        const int hc = (pn - 10) * BM + cw;
        GAS char* p = (GAS char*)((lat ? VLp + ((size_t)sq * KV_LAT + pos) * 512 : VCp + row * 512) + hc);
        GAS char* po = (GAS char*)(outv + ((size_t)(sq * 2 + l) * 256 + (lat ? 0 : pos)) * 512 + hc);
        EPI_ROWS({ if (!lat) { *(GAS f32x4*)(po + bj * 512) = v0; *(GAS f32x4*)(po + bj * 512 + 16) = v1; }
                   *(GAS u32x4*)(p + bj * 256) = pack8(v0, v1); })
            p += (size_t)adv * 512 * 2; po += (size_t)adv * 512 * 4; EPI_PIN(p); EPI_PIN(po); EPI_END
        return false;
    }
};
struct EpiSig {
    bf16_t* proj; bf16_t* URC; bf16_t* URL;
    __device__ __forceinline__ bool operator()(f32x4 (&acc)[2][2][4][2], const Unit& u, int wr, int wc, int fr, int fq) const {
        if (u.pn >= 28 && u.pn < 40) {
            const int pn = u.pn, pm = u.pm; const int cw = 32 * wc + 8 * fq;
            const int chl = (pn - 28) * 256 + wr * 64 + fr; const bool ctx = pm < 32; const int q = pm - 32;
            const int L = ctx ? L_CTX : L_LAT, nseq = ctx ? 32 : 2, sq = ctx ? pm : (q >> 3), pos0 = ctx ? 0 : (q & 7) * 256;
            bf16_t* base = ctx ? URC : URL; const int comp = ((pn - 28) * 256) >> 10; const int ch = chl & 1023;
            GAS char* p = (GAS char*)base + (((size_t)comp * nseq + sq) * 1024 + ch) * L + pos0 + cw;
            EPI_ROWS({ u32x2 w; w.x = pk_fp8x4(v0[0], v0[1], v0[2], v0[3]); w.y = pk_fp8x4(v1[0], v1[1], v1[2], v1[3]); *(GAS u32x2*)(p + bj * 128) = w; }) p += (size_t)adv * L; EPI_PIN(p); EPI_END
            return false;
        }
        GAS char* p = (GAS char*)proj + ((size_t)u.pm * BM + wr * 64 + fr) * INW * 2 + (size_t)(u.pn < 28 ? C_AG : C_HG) + (size_t)u.pn * BM + 32 * wc + 8 * fq;
        EPI_ROWS({ _Pragma("unroll") for (int e = 0; e < 4; ++e) { v0[e] *= sigmoid_f(v0[e]); v1[e] *= sigmoid_f(v1[e]); }
                   u32x2 w; w.x = pk_fp8x4(v0[0], v0[1], v0[2], v0[3]); w.y = pk_fp8x4(v1[0], v1[1], v1[2], v1[3]); *(GAS u32x2*)(p + bj * 128) = w; }) p += (size_t)adv * INW * 2; EPI_PIN(p); EPI_END
        return false;
    }
};
struct EpiT {
    bf16_t* proj;
    __device__ __forceinline__ bool operator()(f32x4 (&acc)[2][2][4][2], const Unit& u, int wr, int wc, int fr, int fq) const {
        GAS char* p = (GAS char*)(proj + ((size_t)u.pm * BM + wr * 64 + fr) * INW + u.pn * BM + 32 * wc + 8 * fq);
        EPI_ROWS({ _Pragma("unroll") for (int e = 0; e < 4; ++e) { v0[e] = fminf(1.f + __builtin_amdgcn_exp2f(v0[e]), 1048576.f); v1[e] = fminf(1.f + __builtin_amdgcn_exp2f(v1[e]), 1048576.f); }
                   *(GAS u32x4*)(p + bj * 256) = pack8(v0, v1); }) p += (size_t)adv * INW * 2; EPI_PIN(p); EPI_END
        return false;
    }
};
struct EpiT8 {
    bf16_t* proj;
    __device__ __forceinline__ bool operator()(f32x4 (&acc)[2][2][4][2], const Unit& u, int wr, int wc, int fr, int fq) const {
        const int g = (u.pn - 44) >> 4;
        GAS char* p = (GAS char*)proj + ((size_t)u.pm * BM + wr * 64 + fr) * INW * 2 + (size_t)(C_GA + g * DM) + (size_t)u.pn * BM + 32 * wc + 8 * fq;
        EPI_ROWS({ _Pragma("unroll") for (int e = 0; e < 4; ++e) { v0[e] = 1.f + __builtin_amdgcn_exp2f(v0[e]); v1[e] = 1.f + __builtin_amdgcn_exp2f(v1[e]); }
                   u32x2 w; w.x = pk_fp8x4(v0[0], v0[1], v0[2], v0[3]); w.y = pk_fp8x4(v1[0], v1[1], v1[2], v1[3]); *(GAS u32x2*)(p + bj * 128) = w; }) p += (size_t)adv * INW * 2; EPI_PIN(p); EPI_END
        return false;
    }
};
struct EpiChan {
    bf16_t* UC; bf16_t* UL;
    __device__ __forceinline__ bool operator()(f32x4 (&acc)[2][2][4][2], const Unit& u, int wr, int wc, int fr, int fq) const {
        const int tt = u.pn, g = u.aux, pm = u.pm; const int rl = wr * 64 + fr, cl = wc * 32 + 8 * fq;
        const bool ctx = tt < 32; const int q = tt - 32, sq = ctx ? tt : (q >> 3), blk = q & 7; const int ldc = ctx ? 512 : 4096;
        bf16_t* base = ctx ? UC : UL; const int coff = ctx ? pm * 256 : pm * 2048 + blk * 256;
        GAS char* p = (GAS char*)(base + (((size_t)sq * 1024 + g * 256 + rl) * ldc + coff + cl));
        EPI_ROWS({ *(GAS u32x4*)(p + bj * 256) = pack8(v0, v1); }) p += (size_t)adv * ldc * 2; EPI_PIN(p); EPI_END
        return false;
    }
};
struct EpiGate {
    bf16_t* BRp; const bf16_t* PR;
    __device__ __forceinline__ bool operator()(f32x4 (&acc)[2][2][4][2], const Unit& u, int wr, int wc, int fr, int fq) const {
        const size_t row = (size_t)u.aux + wr * 64 + fr; const int col = u.pn * BM + wc * 32 + 8 * fq;
        GAS char* p = (GAS char*)(BRp + row * DM + 2048 + col); const GAS char* gp = (const GAS char*)(PR + row * INW + C_FG + col);
        u32x4 gq[8][2]; EPI_LOAD16(gq, gp, INW * 2, 0, 2);
        EPI_ROWS({ f32x4 g0, g1; unpack8(gq[ai * 4 + m][bj], g0, g1); *(GAS u32x4*)(p + bj * 256) = pack8(v0 * g0, v1 * g1); }) p += (size_t)adv * DM * 2; EPI_PIN(p); EPI_END
        return false;
    }
};
struct EpiMerge {
    bf16_t* MGp; const bf16_t* PR;
    __device__ __forceinline__ bool operator()(f32x4 (&acc)[2][2][4][2], const Unit& u, int wr, int wc, int fr, int fq) const {
        const size_t row = (size_t)u.pm * BM + wr * 64 + fr; const int col = u.pn * BM + wc * 32 + 8 * fq; const int seg = u.aux;
        const GAS char* rowb = (const GAS char*)PR + row * INW * 2;
        const GAS char* px_ = rowb + (size_t)(C_GA + (seg == 0 ? 0 : 2 * DM)) * 2 + col;
        if (seg < 2) {
            const GAS char* pf_ = rowb + (size_t)(C_GA + DM + col) * 2;
            const bool s0 = (seg == 0);
#pragma unroll
            for (int hf = 0; hf < 2; ++hf) {
                u32x2 x8[4][2]; u32x4 f16[4][2]; const GAS char* pa[4]; EPI_ADDR4(pa, px_, INW * 2, hf); EPI_ALOAD8H_NOWAIT(x8, pa); EPI_ADDR4(pa, pf_, INW * 2, hf); EPI_ALOAD8_WAIT(f16, pa, x8);
#pragma unroll
                for (int m = 0; m < 4; ++m)
#pragma unroll
                    for (int bj = 0; bj < 2; ++bj) { f32x4 x0, x1, f0, f1; unpack8f8(x8[m][bj], x0, x1); unpack8(f16[m][bj], f0, f1);
#pragma unroll
                        for (int e = 0; e < 4; ++e) { acc[hf][bj][m][0][e] *= (s0 ? f0[e] : x0[e]) * __builtin_amdgcn_rcpf(s0 ? x0[e] : f0[e]); acc[hf][bj][m][1][e] *= (s0 ? f1[e] : x1[e]) * __builtin_amdgcn_rcpf(s0 ? x1[e] : f1[e]); } }
            }
            return true;
        }
        GAS char* q = (GAS char*)(MGp + row * DM + col);
        u32x2 gq[2][4][2]; { const GAS char* pa[4]; EPI_ADDR4(pa, px_, INW * 2, 0); EPI_ALOAD8H_NOWAIT(gq[0], pa); EPI_ADDR4(pa, px_, INW * 2, 1); EPI_ALOAD8H_WAIT(gq[1], pa, gq[0]); }
        EPI_ROWS({ f32x4 g0, g1; unpack8f8(gq[ai][m][bj], g0, g1); _Pragma("unroll") for (int e = 0; e < 4; ++e) { v0[e] *= __builtin_amdgcn_rcpf(g0[e]); v1[e] *= __builtin_amdgcn_rcpf(g1[e]); } *(GAS u32x4*)(q + bj * 256) = pack8(v0, v1); }) q += (size_t)adv * DM * 2; EPI_PIN(q); EPI_END
        return false;
    }
};
struct EpiPart {
    float* Pp;
    __device__ __forceinline__ bool operator()(f32x4 (&acc)[2][2][4][2], const Unit& u, int wr, int wc, int fr, int fq) const {
        GAS char* p = (GAS char*)((bf16_t*)Pp + ((size_t)u.aux * M_LAT + (size_t)u.pm * BM + wr * 64 + fr) * 1024 + u.pn * BM + wc * 32 + 8 * fq);
        EPI_ROWS({ *(GAS u32x4*)(p + bj * 256) = pack8(v0, v1); }) p += (size_t)adv * 1024 * 2; EPI_PIN(p); EPI_END
        return false;
    }
};
struct EpiO16 {
    bf16_t* O;
    __device__ __forceinline__ bool operator()(f32x4 (&acc)[2][2][4][2], const Unit& u, int wr, int wc, int fr, int fq) const {
        GAS char* p = (GAS char*)(O + ((size_t)u.pm * BM + wr * 64 + fr) * DM + u.pn * BM + wc * 32 + 8 * fq);
        EPI_ROWS({ *(GAS u32x4*)(p + bj * 256) = pack8(v0, v1); }) p += (size_t)adv * DM * 2; EPI_PIN(p); EPI_END
        return false;
    }
};
}

namespace att {
constexpr int D = 128, NW = 8, QBLK = 32, KVBLK = 64;
constexpr float SCALE = 0.088388347648318440f;
constexpr float THR = 8.f;
constexpr int LDQ = 2048, LDK = 512, LDO = 4096, LDG = INW;
constexpr size_t SHM_V = KVBLK * D * 2, SHM_K = KVBLK * D * 2, SHM_ATTN = 2 * SHM_V + 2 * SHM_K + NW * 64 * 4;
#define KSWZ(row, colB) ((row) * 256 + ((colB) ^ (((row) & 7) << 4)))
#define SBAR() __builtin_amdgcn_sched_barrier(0)
__device__ __forceinline__ int crow(int r, int hi) { return (r & 3) + 8 * (r >> 2) + 4 * hi; }
__device__ __forceinline__ void partialSM(f32x16& p0, f32x16& p1, float& m_reg, float& mn, float& alpha) {
  constexpr float C = SCALE * 1.4426950408889634f;
  float pmax = p0[0]; for (int r = 1; r < 16; ++r) pmax = fmaxf(pmax, p0[r]); for (int r = 0; r < 16; ++r) pmax = fmaxf(pmax, p1[r]);
  { auto rr = __builtin_amdgcn_permlane32_swap(__float_as_uint(pmax), __float_as_uint(pmax), false, false);
    pmax = fmaxf(__uint_as_float(rr[0]), __uint_as_float(rr[1])); }
  if (__builtin_expect(__all(pmax - m_reg <= THR / SCALE), 1)) { mn = m_reg; alpha = 1.f; }
  else { mn = fmaxf(m_reg, pmax); alpha = __builtin_amdgcn_exp2f((m_reg - mn) * C); m_reg = mn; }
  float mnC = -mn * C;
  for (int r = 0; r < 16; ++r) p0[r] = fmaf(p0[r], C, mnC); for (int r = 0; r < 16; ++r) p1[r] = fmaf(p1[r], C, mnC);
  for (int r = 0; r < 16; ++r) p0[r] = __builtin_amdgcn_exp2f(p0[r]);
}
__device__ __forceinline__ void finishSM(f32x16& p0, f32x16& p1, float alpha, float& l_reg, bf16x8& pa0, bf16x8& pa1, bf16x8& pa2, bf16x8& pa3) {
  for (int r = 0; r < 16; ++r) p1[r] = __builtin_amdgcn_exp2f(p1[r]);
  float ps = 0; for (int r = 0; r < 16; ++r) ps += p0[r]; for (int r = 0; r < 16; ++r) ps += p1[r];
  { auto rr = __builtin_amdgcn_permlane32_swap(__float_as_uint(ps), __float_as_uint(ps), false, false);
    ps = __uint_as_float(rr[0]) + __uint_as_float(rr[1]); }
  l_reg = l_reg * alpha + ps;
#define PK4(P, BASE, OUT) do { unsigned a0 = cvt_pk_bf16(P[BASE + 0], P[BASE + 1]), a1 = cvt_pk_bf16(P[BASE + 2], P[BASE + 3]);   \
    unsigned b0 = cvt_pk_bf16(P[BASE + 4], P[BASE + 5]), b1 = cvt_pk_bf16(P[BASE + 6], P[BASE + 7]);                              \
    auto r0 = __builtin_amdgcn_permlane32_swap(a0, b0, false, false); auto r1 = __builtin_amdgcn_permlane32_swap(a1, b1, false, false); \
    u32x4 w = {r0[0], r1[0], r0[1], r1[1]}; OUT = *reinterpret_cast<bf16x8*>(&w); } while (0)
  PK4(p0, 0, pa0); PK4(p0, 8, pa1); PK4(p1, 0, pa2); PK4(p1, 8, pa3);
#undef PK4
}
__device__ __forceinline__ void qkt(f32x16& p0, f32x16& p1, const bf16_t* Ks, const bf16x8* qr, int r32, int hi) {
  p0 = f32x16{}; p1 = f32x16{};
  for (int d0 = 0; d0 < 8; ++d0) { int cb = (d0 * 16 + hi * 8) * 2;
    bf16x8 b0 = *reinterpret_cast<const bf16x8*>((const char*)Ks + KSWZ(r32, cb));
    bf16x8 b1 = *reinterpret_cast<const bf16x8*>((const char*)Ks + KSWZ(32 + r32, cb));
    p0 = __builtin_amdgcn_mfma_f32_32x32x16_bf16(b0, qr[d0], p0, 0, 0, 0);
    p1 = __builtin_amdgcn_mfma_f32_32x32x16_bf16(b1, qr[d0], p1, 0, 0, 0); }
}
__device__ __forceinline__ int v_st(int k, int c) { const int kk = (k & ~0xC) | ((k & 4) << 1) | ((k & 8) >> 1); return ((kk >> 3) * 4 + (c >> 5)) * 512 + ((kk & 7) * 32 + (c & 31)) * 2; }
__device__ __forceinline__ int v_rd_base(int lane) { return ((lane & 3) << 3) | (((lane >> 2) & 3) << 6) | (((lane >> 4) & 1) << 5) | (((lane >> 5) & 1) << 8); }
constexpr int v_rd_off(int d0, int ks, int half) { return d0 * 512 + ks * 4096 + half * 2048; }
template <int OFF> __device__ __forceinline__ s16x4 tr_read(int vb) {
  s16x4 r; asm volatile("ds_read_b64_tr_b16 %0, %1 offset:%2" : "=&v"(r) : "v"(vb), "i"(OFF) : "memory"); return r;
}
template <int D0> __device__ __forceinline__ void pv_one(f32x16& od, int vb, bf16x8 pa0, bf16x8 pa1, bf16x8 pa2, bf16x8 pa3) {
  const s16x4 l0 = tr_read<v_rd_off(D0, 0, 0)>(vb), h0 = tr_read<v_rd_off(D0, 0, 1)>(vb), l1 = tr_read<v_rd_off(D0, 1, 0)>(vb), h1 = tr_read<v_rd_off(D0, 1, 1)>(vb);
  const s16x4 l2 = tr_read<v_rd_off(D0, 2, 0)>(vb), h2 = tr_read<v_rd_off(D0, 2, 1)>(vb), l3 = tr_read<v_rd_off(D0, 3, 0)>(vb), h3 = tr_read<v_rd_off(D0, 3, 1)>(vb);
  asm volatile("s_waitcnt lgkmcnt(0)" ::: "memory"); SBAR();
#define PK(L, H) (bf16x8){L[0], L[1], L[2], L[3], H[0], H[1], H[2], H[3]}
  od = __builtin_amdgcn_mfma_f32_32x32x16_bf16(pa0, PK(l0, h0), od, 0, 0, 0);
  od = __builtin_amdgcn_mfma_f32_32x32x16_bf16(pa1, PK(l1, h1), od, 0, 0, 0);
  od = __builtin_amdgcn_mfma_f32_32x32x16_bf16(pa2, PK(l2, h2), od, 0, 0, 0);
  od = __builtin_amdgcn_mfma_f32_32x32x16_bf16(pa3, PK(l3, h3), od, 0, 0, 0);
#undef PK
}
__device__ __forceinline__ void pv_d0(f32x16* o, int vb, bf16x8 pa0, bf16x8 pa1, bf16x8 pa2, bf16x8 pa3) {
  pv_one<0>(o[0], vb, pa0, pa1, pa2, pa3); pv_one<1>(o[1], vb, pa0, pa1, pa2, pa3); pv_one<2>(o[2], vb, pa0, pa1, pa2, pa3); pv_one<3>(o[3], vb, pa0, pa1, pa2, pa3);
}
__device__ __forceinline__ void attn_dense_body(const bf16_t* __restrict__ Qb, const bf16_t* __restrict__ Kh, const bf16_t* __restrict__ Vh,
                                                bf16_t* __restrict__ Ob, const bf16_t* __restrict__ Gb, int seq, char* lds, int wid) {
  int lane = lane_id(); asm volatile("" : "+v"(lane));
  const int tid = wid * 64 + lane, r32 = lane & 31, hi = lane >> 5;
  bf16_t* V_lds = (bf16_t*)lds; bf16_t* K_lds = (bf16_t*)(lds + 2 * SHM_V);
  float* ws = (float*)(lds + 2 * SHM_V + 2 * SHM_K) + wid * 64; float* li_l = ws; float* al_l = ws + 32;
  float m_reg = -1e30f, l_reg = 0; f32x16 o[4] = {}; bf16x8 qr[8];
  const unsigned char* Qw = (const unsigned char*)Qb + (long)(wid * QBLK + r32) * LDQ + hi * 8;
#pragma unroll
  for (int d0 = 0; d0 < 8; ++d0) { const u32x2 w8 = *reinterpret_cast<const u32x2*>(Qw + d0 * 16); f32x4 q0, q1; pg8::unpack8f8(w8, q0, q1); qr[d0] = __builtin_bit_cast(bf16x8, pg8::pack8(q0, q1)); }
  const int sr = tid >> 4, sc = (tid & 15) * 8, vst0 = v_st(sr, sc), vst1 = v_st(32 + sr, sc);
  const int vb0 = (int)(uintptr_t)V_lds + v_rd_base(lane);
  struct { bf16x8 vs0, vs1, ks0, ks1; } sr_[2];
#define SLOAD(i, k0) do { sr_[i].vs0 = *reinterpret_cast<const bf16x8*>(&Vh[(long)((k0) + sr) * LDK + sc]); sr_[i].vs1 = *reinterpret_cast<const bf16x8*>(&Vh[(long)((k0) + 32 + sr) * LDK + sc]); \
    sr_[i].ks0 = *reinterpret_cast<const bf16x8*>(&Kh[(long)((k0) + sr) * LDK + sc]); sr_[i].ks1 = *reinterpret_cast<const bf16x8*>(&Kh[(long)((k0) + 32 + sr) * LDK + sc]); } while (0)
#define SWRITE(b, i) do { *(bf16x8*)((char*)V_lds + (b) * SHM_V + vst0) = sr_[i].vs0;          \
    *(bf16x8*)((char*)V_lds + (b) * SHM_V + vst1) = sr_[i].vs1; int kc = sc * 2;               \
    *(bf16x8*)((char*)K_lds + (b) * SHM_K + KSWZ(sr, kc)) = sr_[i].ks0;                       \
    *(bf16x8*)((char*)K_lds + (b) * SHM_K + KSWZ(32 + sr, kc)) = sr_[i].ks1; } while (0)
#define SWAIT() asm volatile("s_waitcnt vmcnt(4)" ::: "memory")
#define RESC(a) do { if (__any((a) < 1.f)) { if (hi == 0) al_l[r32] = (a); asm volatile("s_waitcnt lgkmcnt(0)" ::: "memory"); \
    for (int d = 0; d < 4; ++d) for (int r = 0; r < 16; ++r) o[d][r] *= al_l[crow(r, hi)]; } } while (0)
  f32x16 pA0, pA1, pB0, pB1; float mnA, mnB, alA, alB; bf16x8 pa0, pa1, pa2, pa3; const int NT = seq / KVBLK;
  constexpr int SE = 0, SO = 1;
  SLOAD(SE, 0); asm volatile("s_waitcnt vmcnt(0)" ::: "memory"); SWRITE(0, SE); __syncthreads();
  qkt(pA0, pA1, K_lds, qr, r32, hi); partialSM(pA0, pA1, m_reg, mnA, alA);
  SLOAD(SO, KVBLK); if (2 < NT) SLOAD(SE, 2 * KVBLK);
  SWAIT(); SWRITE(1, SO); __syncthreads();
  for (int j = 1; j + 1 < NT; j += 2) {
    SBAR(); qkt(pB0, pB1, (bf16_t*)((char*)K_lds + SHM_K), qr, r32, hi);
    finishSM(pA0, pA1, alA, l_reg, pa0, pa1, pa2, pa3); SBAR();
    SLOAD(SO, (j + 2) * KVBLK); SBAR();
    pv_d0(o, vb0, pa0, pa1, pa2, pa3); partialSM(pB0, pB1, m_reg, mnB, alB);
    __syncthreads(); SWAIT(); SWRITE(0, SE);
    RESC(alB); __syncthreads();
    SBAR(); qkt(pA0, pA1, K_lds, qr, r32, hi);
    finishSM(pB0, pB1, alB, l_reg, pa0, pa1, pa2, pa3); SBAR();
    if (j + 3 < NT) SLOAD(SE, (j + 3) * KVBLK); SBAR();
    pv_d0(o, vb0 + (int)SHM_V, pa0, pa1, pa2, pa3); partialSM(pA0, pA1, m_reg, mnA, alA);
    __syncthreads(); SWAIT(); SWRITE(1, SO);
    RESC(alA); __syncthreads();
  }
  SBAR(); qkt(pB0, pB1, (bf16_t*)((char*)K_lds + SHM_K), qr, r32, hi);
  finishSM(pA0, pA1, alA, l_reg, pa0, pa1, pa2, pa3); SBAR();
  pv_d0(o, vb0, pa0, pa1, pa2, pa3); partialSM(pB0, pB1, m_reg, mnB, alB);
  __syncthreads(); RESC(alB);
  finishSM(pB0, pB1, alB, l_reg, pa0, pa1, pa2, pa3); SBAR();
  pv_d0(o, vb0 + (int)SHM_V, pa0, pa1, pa2, pa3);
  if (hi == 0) li_l[r32] = l_reg; asm volatile("s_waitcnt lgkmcnt(0)" ::: "memory");
  { const int jq = (r32 & 3) * 32 + (r32 & ~3); const unsigned sel = (unsigned)(r32 & 3) | ((4u + (unsigned)(r32 & 3)) << 8) | 0x0c0c0000u;
    auto quad_tr = [&](unsigned w) -> unsigned {
      const unsigned w0 = (unsigned)__builtin_amdgcn_mov_dpp((int)w, 0x00, 0xF, 0xF, true), w1 = (unsigned)__builtin_amdgcn_mov_dpp((int)w, 0x55, 0xF, 0xF, true);
      const unsigned w2 = (unsigned)__builtin_amdgcn_mov_dpp((int)w, 0xAA, 0xF, 0xF, true), w3 = (unsigned)__builtin_amdgcn_mov_dpp((int)w, 0xFF, 0xF, 0xF, true);
      return __builtin_amdgcn_perm(w1, w0, sel) | (__builtin_amdgcn_perm(w3, w2, sel) << 16); };
    GAS char* op = (GAS char*)Ob + (long)(wid * QBLK + 4 * hi) * LDO * 2 + jq; const GAS char* gp = (const GAS char*)Gb + (long)(wid * QBLK + 4 * hi) * LDG * 2 + jq;
    unsigned gq[16];
#pragma unroll
    for (int r = 0; r < 16; ++r) { gq[r] = *(const GAS unsigned*)gp;
      gp += (long)(((r & 3) == 3) ? 5 : 1) * LDG * 2; asm volatile("" : "+v"(gp)); }
#pragma unroll
    for (int r = 0; r < 16; ++r) { const float rl = __builtin_amdgcn_rcpf(li_l[crow(r, hi)]) * 64.f; const int g = (int)quad_tr(gq[r]);
      const unsigned w = pk_fp8x4(o[0][r] * rl * __builtin_amdgcn_cvt_f32_fp8(g, 0), o[1][r] * rl * __builtin_amdgcn_cvt_f32_fp8(g, 1), o[2][r] * rl * __builtin_amdgcn_cvt_f32_fp8(g, 2), o[3][r] * rl * __builtin_amdgcn_cvt_f32_fp8(g, 3));
      *(GAS unsigned*)op = quad_tr(w);
      op += (long)(((r & 3) == 3) ? 5 : 1) * LDO * 2;
      asm volatile("" : "+v"(op) :: "memory"); } }
  __syncthreads();
#undef SLOAD
#undef SWRITE
#undef SWAIT
#undef RESC
}
#undef KSWZ
#undef SBAR
}

#define XB_TMO      128
#define XB_XCNT(j)  (256  + 64 * (j))
#define XB_XSUB(j)  (1280 + 64 * (j))
#define XB_XGEN(j)  (2304 + 64 * (j))
#define XB_TOP      3328
#define XB_TOPGEN   3392
#define XCD_BAR_WORDS 3456
#define XB_SPIN_CAP (1u << 18)
__device__ __forceinline__ unsigned xb_ld(unsigned* p)              { return __hip_atomic_load(p, __ATOMIC_RELAXED, __HIP_MEMORY_SCOPE_AGENT); }
__device__ __forceinline__ unsigned xb_add(unsigned* p, unsigned v) { return __hip_atomic_fetch_add(p, v, __ATOMIC_RELAXED, __HIP_MEMORY_SCOPE_AGENT); }
__device__ __forceinline__ unsigned xb_xcc_id() { return (unsigned)__builtin_amdgcn_s_getreg((3 << 11) | 20) & 0xFu; }
#define XB_SPIN(cond, bar) do { unsigned _sp = 0; while (cond) { __builtin_amdgcn_s_sleep(1); \
    if ((++_sp & 255u) == 0u) { if (xb_ld(&(bar)[XB_TMO])) break; if (_sp > XB_SPIN_CAP) { atomicAdd(&(bar)[XB_TMO], 1u); break; } } } } while (0)
struct XcdBarrier { unsigned* bar; unsigned x; volatile LAS unsigned* st; };
__device__ __forceinline__ XcdBarrier xcd_barrier_post(unsigned* bar, volatile LAS unsigned* st) {
    XcdBarrier b; b.bar = bar; b.x = (unsigned)__builtin_amdgcn_readfirstlane((int)xb_xcc_id()); b.st = st;
    if (threadIdx.x == 0) (void)xb_add(&bar[XB_XCNT(b.x)], 1u);
    return b;
}
__device__ __forceinline__ void xcd_barrier_complete(unsigned* bar, unsigned x, unsigned& nloc, unsigned& nx) {
    const unsigned G = gridDim.x * gridDim.y * gridDim.z;
    unsigned sum, cnt, mine, sp = 0u;
    for (;;) {
        sum = 0u; cnt = 0u; mine = 0u;
#pragma unroll
        for (unsigned j = 0; j < 16; ++j) { const unsigned c = xb_ld(&bar[XB_XCNT(j)]); sum += c; cnt += (c > 0u) ? 1u : 0u; mine = (j == x) ? c : mine; }
        if (sum == G) break;
        __builtin_amdgcn_s_sleep(1);
        if ((++sp & 255u) == 0u) { if (xb_ld(&bar[XB_TMO])) break; if (sp > XB_SPIN_CAP) { atomicAdd(&bar[XB_TMO], 1u); break; } }
    }
    nloc = mine > 0u ? mine : 1u; nx = cnt > 0u ? cnt : 1u;
}
__device__ __forceinline__ void xcd_barrier(const XcdBarrier& b) {
    asm volatile("s_waitcnt vmcnt(0)" ::: "memory");
    __syncthreads();
    if (threadIdx.x == 0) {
        unsigned* bar = b.bar; unsigned bx_ = b.x; asm volatile("" : "+s"(bar), "+s"(bx_));
        __builtin_amdgcn_s_waitcnt(0);
        unsigned nloc = b.st[0], nx = b.st[1];
        if (nloc == 0u) { xcd_barrier_complete(bar, bx_, nloc, nx); b.st[0] = nloc; b.st[1] = nx; }
        const unsigned old = xb_add(&bar[XB_XSUB(bx_)], 1u);
        const unsigned gen = old / nloc;
        if (old + 1u == (gen + 1u) * nloc) {
            __builtin_amdgcn_fence(__ATOMIC_RELEASE, "agent");
            asm volatile("s_waitcnt vmcnt(0)" ::: "memory");
            const unsigned og = xb_add(&bar[XB_TOP], 1u);
            const unsigned tg = og / nx;
            if (og + 1u == (tg + 1u) * nx) xb_add(&bar[XB_TOPGEN], 1u);
            else XB_SPIN(xb_ld(&bar[XB_TOPGEN]) == tg, bar);
            __builtin_amdgcn_fence(__ATOMIC_ACQUIRE, "agent");
            xb_add(&bar[XB_XGEN(bx_)], 1u);
            asm volatile("s_waitcnt vmcnt(0)" ::: "memory");
        } else {
            XB_SPIN(xb_ld(&bar[XB_XGEN(bx_)]) == gen, bar);
            __builtin_amdgcn_fence(__ATOMIC_ACQUIRE, "agent");
            asm volatile("s_waitcnt vmcnt(0)" ::: "memory");
        }
    }
    __syncthreads();
}

constexpr int NWAVES = 8;
constexpr int RING_BYTES = 131072, MISC_OFF = RING_BYTES + 320, LDS_BYTES = 147456;
constexpr int CW_BAR = 4096;
constexpr int CW_Q = 8192;
constexpr int N_PHASES = 17;

typedef const float GAS* gfp_t; typedef const gfp_t __attribute__((address_space(4)))* kargp_t;
struct KargTab { kargp_t p; __device__ __forceinline__ const float* operator[](int k) const { return (const float*)p[k]; } };
struct Args { const float* in[27]; float* out; unsigned char* ws; int ph_lo, ph_hi; };

enum { I_XP = 0, I_XS, I_CK, I_CV, I_C, I_CCTX, I_WMOD, I_BMOD, I_GPRE, I_WIN, I_QN, I_KN, I_HSW, I_HSB, I_HW1, I_HB1, I_HW2, I_HB2, I_HW3, I_HB3, I_HFR, I_HBIAS, I_WAO, I_WFO, I_WHO, I_WOUT, I_GPOST };

__device__ __forceinline__ void transpose_item(const float* W, int N, bf16_t* WT, int ldt, int koff, LAS float* scr, int item, int lane, unsigned char* w8 = nullptr, int n8off = 0, float s8 = 64.f) {
    const int nblk = N / 64, kb = item / nblk, nb = item % nblk, k0 = 64 * kb, n0 = 64 * nb;
    const int kq = lane >> 4, nq = lane & 15;
    const float* src = W + (size_t)(k0 + kq) * N + n0 + 4 * nq;
    f32x4 v[16];
#pragma unroll
    for (int i = 0; i < 16; ++i) v[i] = __builtin_nontemporal_load((const f32x4*)(src + (size_t)(4 * i) * N));
#pragma unroll
    for (int i = 0; i < 16; ++i) *(LAS f32x4*)(scr + (4 * i + kq) * 64 + 4 * (nq ^ (i >> 1))) = v[i];
    LDS_WAIT(); asm volatile("" ::: "memory");
    const int c = lane & 7, nn = lane >> 3;
#pragma unroll
    for (int j = 0; j < 8; ++j) { const int n = nn + 8 * j; const LAS float* s = scr + (8 * c) * 64 + (n ^ (4 * c));
        if (w8) { u32x2 o8; o8.x = pk_fp8x4(s[0 * 64] * s8, s[1 * 64] * s8, s[2 * 64] * s8, s[3 * 64] * s8); o8.y = pk_fp8x4(s[4 * 64] * s8, s[5 * 64] * s8, s[6 * 64] * s8, s[7 * 64] * s8);
                  *(u32x2*)(w8 + (size_t)(n0 + n - n8off) * ldt + k0 + 8 * c) = o8; }
        else { u32x4 o; o.x = cvt_pk_bf16(s[0 * 64], s[1 * 64]); o.y = cvt_pk_bf16(s[2 * 64], s[3 * 64]); o.z = cvt_pk_bf16(s[4 * 64], s[5 * 64]); o.w = cvt_pk_bf16(s[6 * 64], s[7 * 64]);
               *(u32x4*)(WT + (size_t)(n0 + n) * ldt + koff + k0 + 8 * c) = o; } }
    LDS_WAIT(); asm volatile("" ::: "memory");
}

constexpr float HY_MIN_DECAY = -15.350567286626973f;
constexpr float HY_MAX_DECAY = -3.0701134573253945f;

__device__ __forceinline__ void prenorm_store(const f32x4 (&v)[16], const float* gpre, const float* mod  , bf16_t* hrow, unsigned char* h8row, int lane) {
    float ss = 0.f;
#pragma unroll
    for (int j = 0; j < 16; ++j) ss += (v[j].x * v[j].x + v[j].y * v[j].y) + (v[j].z * v[j].z + v[j].w * v[j].w);
    const float rs = 1.0f / sqrtf(wave_sum(ss) * (1.f / DM) + EPS);
#pragma unroll
    for (int j = 0; j < 16; ++j) { const int c = 4 * lane + 256 * j;
        const f32x4 g = *(const f32x4*)(gpre + c), sh = *(const f32x4*)(mod + c), sc = *(const f32x4*)(mod + DM + c);
        const f32x4 y = (v[j] * rs) * g * (sc + 1.0f) + sh;
        u32x2 w; w.x = cvt_pk_bf16(y.x, y.y); w.y = cvt_pk_bf16(y.z, y.w);
        *(u32x2*)(hrow + c) = w; *(unsigned*)(h8row + c) = pk_fp8x4(y.x, y.y, y.z, y.w); }
}

namespace hy {
constexpr int RV_PER_LAYER = 2 * 1024 * 512 + 2 * 1024 * 4096;
constexpr int LAT_LDS = 17408, ZSEQ = 4352;
__device__ __forceinline__ bf16x8 afragp(const LAS unsigned* p, unsigned sh) {
    const unsigned w0 = p[0], w1 = p[1], w2 = p[2], w3 = p[3], w4 = p[4];
    u32x4 o; o.x = __builtin_amdgcn_alignbit(w1, w0, sh); o.y = __builtin_amdgcn_alignbit(w2, w1, sh); o.z = __builtin_amdgcn_alignbit(w3, w2, sh); o.w = __builtin_amdgcn_alignbit(w4, w3, sh);
    return __builtin_bit_cast(bf16x8, o);
}
__device__ __forceinline__ bf16x8 afrag(const LAS unsigned* rv, int q0) {
    const int e = q0 >> 1; const unsigned sh = (unsigned)(q0 & 1) << 4;
    const unsigned w0 = rv[e], w1 = rv[e + 1], w2 = rv[e + 2], w3 = rv[e + 3], w4 = rv[e + 4];
    u32x4 o; o.x = __builtin_amdgcn_alignbit(w1, w0, sh); o.y = __builtin_amdgcn_alignbit(w2, w1, sh); o.z = __builtin_amdgcn_alignbit(w3, w2, sh); o.w = __builtin_amdgcn_alignbit(w4, w3, sh);
    return __builtin_bit_cast(bf16x8, o);
}
struct ScW { float w0, w1, w2, b; };
__device__ __forceinline__ ScW scw(const float* sw, const float* sb, int uc) { ScW w; w.w0 = sw[uc]; w.w1 = sw[3072 + uc]; w.w2 = sw[6144 + uc]; w.b = sb[uc]; return w; }
__device__ __forceinline__ f32x4 bf4(u32x2 w) { return (f32x4){bf2f(w.x & 0xffffu), bf2f(w.x >> 16), bf2f(w.y & 0xffffu), bf2f(w.y >> 16)}; }
typedef unsigned char u8_t;
__device__ __forceinline__ float f8f(unsigned b) { return __builtin_amdgcn_cvt_f32_fp8((int)b, 0); }
struct __attribute__((packed, aligned(4))) U3a4 { unsigned a, b, c; };
struct __attribute__((packed, aligned(4))) U4a4 { unsigned a, b, c, d; };
__device__ __forceinline__ f32x4 sc4(const u8_t* p, bool has_prev, bool has_next, const ScW w) {
    const U3a4 r = *(const U3a4*)(p - 4); const auto lo = __builtin_amdgcn_cvt_pk_f32_fp8((int)r.b, false), hi = __builtin_amdgcn_cvt_pk_f32_fp8((int)r.b, true);
    const f32x4 x = {lo[0], lo[1], hi[0], hi[1]}; const float pv = has_prev ? __builtin_amdgcn_cvt_f32_fp8((int)r.a, 3) : 0.f, nx = has_next ? __builtin_amdgcn_cvt_f32_fp8((int)r.c, 0) : 0.f;
    return (f32x4){w.b + w.w0 * pv + w.w1 * x[0] + w.w2 * x[1], w.b + w.w0 * x[0] + w.w1 * x[1] + w.w2 * x[2], w.b + w.w0 * x[1] + w.w1 * x[2] + w.w2 * x[3], w.b + w.w0 * x[2] + w.w1 * x[3] + w.w2 * nx};
}
__device__ __forceinline__ bf16x8 sc8(const u8_t* p, bool has_prev, bool has_next, const ScW w) {
    const U4a4 r = *(const U4a4*)(p - 4); const float pv = has_prev ? __builtin_amdgcn_cvt_f32_fp8((int)r.a, 3) : 0.f, nx = has_next ? __builtin_amdgcn_cvt_f32_fp8((int)r.d, 0) : 0.f;
    const auto a0 = __builtin_amdgcn_cvt_pk_f32_fp8((int)r.b, false), a1 = __builtin_amdgcn_cvt_pk_f32_fp8((int)r.b, true), b0 = __builtin_amdgcn_cvt_pk_f32_fp8((int)r.c, false), b1 = __builtin_amdgcn_cvt_pk_f32_fp8((int)r.c, true);
    const float x[10] = {pv, a0[0], a0[1], a1[0], a1[1], b0[0], b0[1], b1[0], b1[1], nx}; float y[8];
#pragma unroll
    for (int e = 0; e < 8; ++e) y[e] = w.b + w.w0 * x[e] + w.w1 * x[e + 1] + w.w2 * x[e + 2];
    u32x4 o; o.x = cvt_pk_bf16(y[0], y[1]); o.y = cvt_pk_bf16(y[2], y[3]); o.z = cvt_pk_bf16(y[4], y[5]); o.w = cvt_pk_bf16(y[6], y[7]); return __builtin_bit_cast(bf16x8, o);
}
template <int H>
__device__ __forceinline__ void ctx_conv_half(const LAS unsigned* rv, const bf16x8 (&B)[16], f32x16 (&acc)[4], int i, int kh) {
    int base = 255 - i + 8 * kh; asm volatile("" : "+v"(base));
    const LAS unsigned* pb = rv + (base >> 1) - 8 * 14; const unsigned sh = (unsigned)(base & 1) << 4;
#pragma unroll
    for (int m = (H ? -7 : -15); m <= (H ? 14 : 6); ++m) {
        const bf16x8 A = afragp(pb + 8 * (14 - m), sh);
#pragma unroll
        for (int j = 0; j < 4; ++j) { const int js = 2 * (4 * H + j) - m; if (js >= 0 && js < 16) acc[j] = __builtin_amdgcn_mfma_f32_32x32x16_bf16(A, B[js], acc[j], 0, 0, 0); }
        if ((m & 1) == 0) asm volatile("" ::: "memory");
    }
}
#define HY_PK4(P, BASE, OUT) do { unsigned a0 = cvt_pk_bf16(P[BASE + 0], P[BASE + 1]), a1 = cvt_pk_bf16(P[BASE + 2], P[BASE + 3]);   \
    unsigned b0 = cvt_pk_bf16(P[BASE + 4], P[BASE + 5]), b1 = cvt_pk_bf16(P[BASE + 6], P[BASE + 7]);                              \
    auto r0 = __builtin_amdgcn_permlane32_swap(a0, b0, false, false); auto r1 = __builtin_amdgcn_permlane32_swap(a1, b1, false, false); \
    u32x4 w = {r0[0], r1[0], r0[1], r1[1]}; OUT = __builtin_bit_cast(bf16x8, w); } while (0)
template <int H>
__device__ __forceinline__ void ctx_pass1(const LAS unsigned* rv, const bf16x8 (&B)[16], bf16x8 (&B2)[16], const u8_t* x1p, const ScW w1c, int i, int kh) {
    f32x16 acc[4];
#pragma unroll
    for (int j = 0; j < 4; ++j) acc[j] = f32x16{};
    ctx_conv_half<H>(rv, B, acc, i, kh);
#pragma unroll
    for (int j = 0; j < 4; ++j) { const int it = 4 * H + j;
#pragma unroll
        for (int g = 0; g < 4; ++g) { const int ps = 32 * it + 8 * g + 4 * kh; const f32x4 x = sc4(x1p + 32 * it + 8 * g, ps > 0, ps + 4 < 256, w1c);
#pragma unroll
            for (int e = 0; e < 4; ++e) acc[j][4 * g + e] *= x[e]; }
        HY_PK4(acc[j], 0, B2[2 * it]); HY_PK4(acc[j], 8, B2[2 * it + 1]);
        asm volatile("" ::: "memory"); }
}
template <int H>
__device__ __forceinline__ void ctx_pass2(const LAS unsigned* rv, const bf16x8 (&B2)[16], const u8_t* x2p, const ScW w2c, bf16_t* yp, int i, int kh) {
    f32x16 acc[4];
#pragma unroll
    for (int j = 0; j < 4; ++j) acc[j] = f32x16{};
    ctx_conv_half<H>(rv, B2, acc, i, kh);
#pragma unroll
    for (int j = 0; j < 4; ++j) { const int it = 4 * H + j;
#pragma unroll
        for (int g = 0; g < 4; ++g) { const int ps = 32 * it + 8 * g + 4 * kh; const f32x4 x = sc4(x2p + 32 * it + 8 * g, ps > 0, ps + 4 < 256, w2c);
            u32x2 w; w.x = cvt_pk_bf16(acc[j][4 * g] * x[0], acc[j][4 * g + 1] * x[1]); w.y = cvt_pk_bf16(acc[j][4 * g + 2] * x[2], acc[j][4 * g + 3] * x[3]);
            *(u32x2*)(yp + 32 * it + 8 * g) = w; }
        asm volatile("" ::: "memory"); }
}
__device__ __forceinline__ void ctx_task(LAS unsigned char* lw, const bf16_t* rvg, const u8_t* ut, bf16_t* y2, const float* sw, const float* sb, int c, int lane) {
    const int n = lane & 31, kh = lane >> 5;
    LAS unsigned* rv0 = (LAS unsigned*)lw; LAS unsigned* rv1 = (LAS unsigned*)(lw + 1024);
    *(LAS u32x4*)(lw + lane * 16) = *(const u32x4*)(rvg + lane * 8);
    *(LAS u32x4*)(lw + 1024 + lane * 16) = *(const u32x4*)(rvg + (size_t)1024 * 512 + lane * 8);
    const size_t sstr = (size_t)1024 * 256;
    const u8_t* vp = ut + (size_t)n * sstr + 8 * kh;
    bf16x8 B[16], B2[16];
    const ScW wv = scw(sw, sb, c), wx1 = scw(sw, sb, 1024 + c), wx2 = scw(sw, sb, 2048 + c);
#pragma unroll
    for (int js = 0; js < 16; ++js) B[js] = sc8(vp + 16 * js, 16 * js + 8 * kh > 0, 16 * js + 8 * kh + 8 < 256, wv);
    LDS_WAIT(); asm volatile("" ::: "memory");
    const u8_t* x1p = ut + (size_t)32 * sstr + (size_t)n * sstr + 4 * kh;
    ctx_pass1<0>(rv0, B, B2, x1p, wx1, n, kh);
    ctx_pass1<1>(rv0, B, B2, x1p, wx1, n, kh);
    const u8_t* x2p = ut + (size_t)64 * sstr + (size_t)n * sstr + 4 * kh; bf16_t* yp = y2 + (size_t)n * sstr + 4 * kh;
    ctx_pass2<0>(rv1, B2, x2p, wx2, yp, n, kh);
    ctx_pass2<1>(rv1, B2, x2p, wx2, yp, n, kh);
    LDS_WAIT(); asm volatile("" ::: "memory");
}
__device__ __forceinline__ void lat_conv(const LAS unsigned* rv, const LAS unsigned char* zl  , const LAS unsigned char* zz  , f32x16 (&acc)[4], int i, int kh, int a) {
    int base = 2047 - i + 8 * kh; asm volatile("" : "+v"(base));
    const LAS unsigned* pb = rv + (base >> 1); const unsigned sh = (unsigned)(base & 1) << 4;
    bf16x8 ring[8];
#pragma unroll
    for (int m = -127; m <= -121; ++m) ring[(m + 128) & 7] = afragp(pb + 8 * 121 + 8 * (-121 - m), sh);
    const LAS unsigned* pit = pb + 8 * 120 - 56;
    int G = a + 15;
    const LAS unsigned char* zc = ((unsigned)G < 16u) ? zl + 272 * G + 16 * kh : zz;
    u32x4 bn[2]; bn[0] = *(const LAS u32x4*)(zc + 224); bn[1] = *(const LAS u32x4*)(zc + 192);
    for (int ub = -127; ub <= 120; ub += 8) {
        --G; const LAS unsigned char* zn = ((unsigned)G < 16u) ? zl + 272 * G + 16 * kh : zz;
#pragma unroll
        for (int k8 = 0; k8 < 8; ++k8) {
            ring[k8 & 7] = afragp(pit + 8 * (7 - k8), sh);
            const bf16x8 Bf = __builtin_bit_cast(bf16x8, bn[k8 & 1]);
            bn[k8 & 1] = (k8 < 6) ? *(const LAS u32x4*)(zc + 32 * (5 - k8)) : *(const LAS u32x4*)(zn + 32 * (13 - k8));
#pragma unroll
            for (int x = 0; x < 4; ++x) acc[x] = __builtin_amdgcn_mfma_f32_32x32x16_bf16(ring[(1 + k8 + 2 * x) & 7], Bf, acc[x], 0, 0, 0);
        }
        pit -= 64; zc = zn;
    }
}
__device__ __forceinline__ void lat_task(LAS unsigned char* lw, const bf16_t* rvg, const u8_t* ut, bf16_t* y2, const float* sw, const float* sb, int c, int lane) {
    const int n = lane & 31, kh = lane >> 5, a = n & 15, sq = n >> 4;
    const ScW wv = scw(sw, sb, c), wx1 = scw(sw, sb, 1024 + c), wx2 = scw(sw, sb, 2048 + c);
    const LAS unsigned char* zz = lw + 16928; { unsigned zr_ = 0u; asm volatile("" : "+v"(zr_)); if (lane < 16) *(LAS u32x4*)(lw + 16928 + lane * 16) = (u32x4){zr_, zr_, zr_, zr_}; }
    LAS unsigned* rv = (LAS unsigned*)(lw + 32); LAS unsigned char* zb = lw + 8224; const LAS unsigned char* zl = zb + sq * ZSEQ;
    const size_t sstr = (size_t)1024 * 2048;
#pragma unroll
    for (int j = 0; j < 8; ++j) *(LAS u32x4*)(lw + 32 + (lane + 64 * j) * 16) = *(const u32x4*)(rvg + (lane + 64 * j) * 8);
#pragma unroll
    for (int s2 = 0; s2 < 2; ++s2)
#pragma unroll
        for (int j = 0; j < 4; ++j) { const int p = 8 * (lane + 64 * j); *(LAS bf16x8*)(zb + s2 * ZSEQ + 2 * p + 16 * (p >> 7)) = sc8(ut + (size_t)s2 * sstr + p, p > 0, p + 8 < 2048, wv); }
    f32x16 acc[4];
#pragma unroll
    for (int x = 0; x < 4; ++x) acc[x] = f32x16{};
    LDS_WAIT(); asm volatile("" ::: "memory");
    lat_conv(rv, zl, zz, acc, n, kh, a);
    LDS_WAIT(); asm volatile("" ::: "memory");
    const u8_t* x1p = ut + (size_t)2 * sstr + (size_t)sq * sstr + 128 * a + 4 * kh;
#pragma unroll
    for (int x = 0; x < 4; ++x)
#pragma unroll
        for (int g = 0; g < 4; ++g) { const int t = 128 * a + 32 * x + 8 * g + 4 * kh; const f32x4 xv = sc4(x1p + 32 * x + 8 * g, t > 0, t + 4 < 2048, wx1);
            u32x2 w; w.x = cvt_pk_bf16(acc[x][4 * g] * xv[0], acc[x][4 * g + 1] * xv[1]); w.y = cvt_pk_bf16(acc[x][4 * g + 2] * xv[2], acc[x][4 * g + 3] * xv[3]);
            *(LAS u32x2*)(zb + sq * ZSEQ + 2 * t + 16 * a) = w; }
#pragma unroll
    for (int j = 0; j < 8; ++j) *(LAS u32x4*)(lw + 32 + (lane + 64 * j) * 16) = *(const u32x4*)(rvg + (size_t)1024 * 4096 + (lane + 64 * j) * 8);
#pragma unroll
    for (int x = 0; x < 4; ++x) acc[x] = f32x16{};
    LDS_WAIT(); asm volatile("" ::: "memory");
    lat_conv(rv, zl, zz, acc, n, kh, a);
    const u8_t* x2p = ut + (size_t)4 * sstr + (size_t)sq * sstr + 128 * a + 4 * kh; bf16_t* yp = y2 + (size_t)sq * sstr + 128 * a + 4 * kh;
#pragma unroll
    for (int x = 0; x < 4; ++x)
#pragma unroll
        for (int g = 0; g < 4; ++g) { const int t = 128 * a + 32 * x + 8 * g + 4 * kh; const f32x4 xv = sc4(x2p + 32 * x + 8 * g, t > 0, t + 4 < 2048, wx2);
            u32x2 w; w.x = cvt_pk_bf16(acc[x][4 * g] * xv[0], acc[x][4 * g + 1] * xv[1]); w.y = cvt_pk_bf16(acc[x][4 * g + 2] * xv[2], acc[x][4 * g + 3] * xv[3]);
            *(u32x2*)(yp + 32 * x + 8 * g) = w; }
    LDS_WAIT(); asm volatile("" ::: "memory");
}
}

#define WIN ((bf16_t*)(ws + WS_WIN))
#define H8 ((unsigned char*)(ws + WS_H8))
#define WIN8 ((unsigned char*)(ws + WS_WIN8))
#define WM ((bf16_t*)(ws + WS_WM))
#define WO ((bf16_t*)(ws + WS_WO))
#define Hb ((bf16_t*)(ws + WS_H))
#define PROJ ((bf16_t*)(ws + WS_PROJ))
#define URC ((bf16_t*)(ws + WS_QKV + 2 * MiB))
#define URL ((bf16_t*)(ws + WS_QKV + 2 * MiB) + (size_t)3 * 32 * 1024 * 256)
#define Qb ((bf16_t*)(ws + WS_Q))
#define KC ((bf16_t*)(ws + WS_KC))
#define VC ((bf16_t*)(ws + WS_VC))
#define KL ((bf16_t*)(ws + WS_KL))
#define VL ((bf16_t*)(ws + WS_VL))
#define BR ((bf16_t*)(ws + WS_BR))
#define UCSC ((bf16_t*)(ws + WS_UCSC))
#define UCSL ((bf16_t*)(ws + WS_UCSL))
#define Y2C ((bf16_t*)(ws + WS_Z1))
#define Y2L ((bf16_t*)(ws + WS_Z1) + (size_t)32 * 1024 * 256)
#define Pb ((float*)(ws + WS_P))
#define MG ((bf16_t*)(ws + WS_MG))
#define Ob ((float*)(ws + WS_O))
#define X1 ((float*)(ws + WS_X1))
#define MODP ((float*)(ws + WS_MODP))
#define MOD ((float*)(ws + WS_MOD))
#define HRAW ((float*)(ws + WS_HRAW))
#define PART ((float*)(ws + WS_PART))
#define INVN ((float*)(ws + WS_INVN))
#define RVT ((bf16_t*)(ws + WS_TT))
#define FNP ((float*)(ws + WS_P))
#define CS ((bf16_t*)(ws + WS_CS))
#define FL256 ((bf16_t*)(ws + WS_FL256))
#define FL2048 ((bf16_t*)(ws + WS_FL2048))
__global__ void __launch_bounds__(NWAVES * 64, 2) mega_fwd(Args args) {
    extern __shared__ __attribute__((aligned(16))) unsigned char lds[];
    LAS unsigned char* const ldsp = (LAS unsigned char*)lds;
    volatile LAS unsigned* const MISC = (volatile LAS unsigned*)(ldsp + MISC_OFF);
    const int wave = __builtin_amdgcn_readfirstlane((int)threadIdx.x >> 6);
    const int G0 = gridDim.x, bx0 = blockIdx.x;
#define PHASE_LOCALS int G = G0, bx = bx0; asm volatile("" : "+s"(G), "+s"(bx)); const int gw = bx * NWAVES + wave, NGW = G * NWAVES, NGT = G * NWAVES * 64; (void)gw; (void)NGW; (void)NGT; int lane = lane_id(); asm volatile("" : "+v"(lane)); GAS unsigned char* ws = (GAS unsigned char*)ws0; asm volatile("" : "+s"(ws)); kargp_t kargp_ = (kargp_t)__builtin_amdgcn_kernarg_segment_ptr(); asm volatile("" : "+s"(kargp_)); const KargTab karg{kargp_};         const int gt = (bx * NWAVES + wave) * 64 + lane; (void)gt;
    unsigned char* const ws0 = args.ws;
    unsigned* const ctl = (unsigned*)(ws0 + WS_CTL);
    for (int u = (int)threadIdx.x; u < (LDS_BYTES - RING_BYTES) / 4; u += NWAVES * 64) ((LAS unsigned*)(ldsp + RING_BYTES))[u] = 0u;
    __syncthreads();
#if MK_PER_PHASE
    XcdBarrier bar; bar.bar = ctl + CW_BAR; bar.x = 0; bar.st = nullptr;
#define GRID_BAR() do { } while (0)
#else
    XcdBarrier bar = xcd_barrier_post(ctl + CW_BAR, MISC + 8);
#define GRID_BAR() xcd_barrier(bar)
#endif
#if MK_PER_PHASE
    const int lo = args.ph_lo, hi = args.ph_hi;
#else
    constexpr int lo = 0, hi = N_PHASES;
#endif
#ifndef PHASE_MASK
#define PHASE_MASK 0x3ff
#endif
#define EN(j) (((PHASE_MASK) >> (j)) & 1)
#ifndef SUB_MASK
#define SUB_MASK 0x7f
#endif
#define SUB(j) (((SUB_MASK) >> (j)) & 1)
#define IN(k) (lo <= (k) && (k) < hi)
#define SEAM(k) do { if (IN(k) && IN((k) + 1)) GRID_BAR(); } while (0)

#define x_prompt (karg[I_XP])
#define x_sample (karg[I_XS])
    float* const out = args.out;
    float* const out_k = out + (size_t)MTOK * DM; float* const out_v = out_k + (size_t)32 * 2 * 256 * 512;
    LAS float* const scr = (LAS float*)(ldsp + wave * 16384);

    if (EN(0) && IN(0)) { PHASE_LOCALS
        {
            constexpr int I_IN = (DM / 64) * (INW / 64), I_AO = (2048 / 64) * (DM / 64), I_FO = (1024 / 64) * (DM / 64), I_OUT = (DM / 64) * (DM / 64);
            constexpr int I_IN2 = I_IN / 2, NBI = INW / 64;
            constexpr int PER_L = I_IN2 + I_AO + 2 * I_FO + I_OUT;
            for (int it = gw; it < 2 * PER_L; it += NGW) {
                const int l = 1 - it / PER_L; int r = it % PER_L;
                if (r < I_IN2) { const int nb = r % NBI, kbp = r / NBI; const bool f8g = nb >= (C_GA / 64), f8a = (nb >= C_AG / 64) && (nb < C_FIN / 64), f8q = nb < 2048 / 64, f8h = (nb >= C_HV / 64) && (nb < C_GA / 64);
                    const float* wsrc = karg[I_WIN] + (size_t)l * DM * INW; unsigned char* w8 = (f8g || f8a || f8q || f8h) ? WIN8 + (size_t)l * N8 * DM : nullptr; const int n8off = f8q ? 0 : f8a ? C_AG - 2048 : f8h ? C_HV - 4096 : C_GA - 8192;
                    const float s8 = f8g ? -64.f * 1.4426950408889634f : 64.f;
                    transpose_item(wsrc, INW, WIN + (size_t)l * INW * DM, DM, 0, scr, (2 * kbp) * NBI + nb, lane, w8, n8off, s8);
                    transpose_item(wsrc, INW, WIN + (size_t)l * INW * DM, DM, 0, scr, (2 * kbp + 1) * NBI + nb, lane, w8, n8off, s8); continue; } r -= I_IN2;
                if (r < I_AO) { transpose_item(karg[I_WAO] + (size_t)l * 2048 * DM, DM, WM + (size_t)l * DM * DM, 2 * DM, 0, scr, r, lane, (unsigned char*)(WM + (size_t)l * DM * DM), 0); continue; } r -= I_AO;
                if (r < I_FO) { transpose_item(karg[I_WFO] + (size_t)l * 1024 * DM, DM, WM + (size_t)l * DM * DM, DM, 2048, scr, r, lane); continue; } r -= I_FO;
                if (r < I_FO) { transpose_item(karg[I_WHO] + (size_t)l * 1024 * DM, DM, WM + (size_t)l * DM * DM, 2 * DM, 0, scr, r, lane, (unsigned char*)(WM + (size_t)l * DM * DM) + 6144, 0); continue; } r -= I_FO;
                transpose_item(karg[I_WOUT] + (size_t)l * DM * DM, DM, WO + (size_t)l * DM * DM, DM, 0, scr, r, lane);
            }
        }
        {
            const float* cctx = karg[I_CCTX]; const float* cc = karg[I_C];
            for (int it = gw; it < 2 * 32 * 48; it += NGW) {
                const int l = it / 1536, r = it % 1536, kc = r / 48, nb = r % 48;
                const float* W = karg[I_WMOD] + ((size_t)l * DM + kc * 128) * 12288 + nb * 256 + lane * 4;
                f32x4 a0 = {0.f, 0.f, 0.f, 0.f}, a1 = a0, a2 = a0;
#pragma unroll 4
                for (int k = 0; k < 128; ++k) {
                    const int kk = kc * 128 + k;
                    const float s0 = silu_f(cctx[kk]), s1 = silu_f(cc[kk]), s2 = silu_f(cc[DM + kk]);
                    const f32x4 w = __builtin_nontemporal_load((const f32x4*)(W + (size_t)k * 12288));
                    a0 += w * s0; a1 += w * s1; a2 += w * s2;
                }
                float* o = MODP + ((size_t)(l * 32 + kc) * 3) * 12288 + nb * 256 + lane * 4;
                *(f32x4*)o = a0; *(f32x4*)(o + 12288) = a1; *(f32x4*)(o + 2 * 12288) = a2;
            }
        }
        {
            LAS float* feats = scr;
            LAS float* hh = scr + 32 * 36;
            for (int it = gw; it < 2 * 72 * 8; it += NGW) {
                const int l = it / 576, r = it % 576, chunk = r >> 3, cb = r & 7;
                const int Lsel = chunk < 8 ? 0 : 1, L = Lsel ? 2048 : 256, p0 = (Lsel ? chunk - 8 : chunk) * 32;
                const float* w1 = karg[I_HW1] + l * 33 * 64; const float* w2 = karg[I_HW2] + l * 64 * 64;
                const float* w3 = karg[I_HW3] + (size_t)l * 64 * 4096; const float* b3 = karg[I_HB3] + l * 4096;
                const float fr = karg[I_HFR][l * 64 + lane] * 0.15915494309189535f;
                const float bb1 = karg[I_HB1][l * 64 + lane], bb2 = karg[I_HB2][l * 64 + lane];
                if (lane < 33) {
                    for (int p = 0; p < 32; ++p) { const int pos = p0 + p; float f;
                        if (lane == 0) f = (float)pos / (float)L;
                        else if (lane <= 16) { const int mm = (pos * lane) % L; f = cospif(2.0f * (float)mm / (float)L); }
                        else { const int mm = (pos * (lane - 16)) % L; f = sinpif(2.0f * (float)mm / (float)L); }
                        feats[p * 36 + lane] = f; }
                }
                LDS_WAIT(); asm volatile("" ::: "memory");
                { float wc1[33];
#pragma unroll
                  for (int i = 0; i < 33; ++i) wc1[i] = w1[i * 64 + lane];
                  for (int p = 0; p < 32; ++p) { float a = bb1;
#pragma unroll
                      for (int i = 0; i < 33; ++i) a = fmaf(feats[p * 36 + i], wc1[i], a);
                      hh[p * 68 + lane] = __builtin_amdgcn_sinf(fr * a); } }
                LDS_WAIT(); asm volatile("" ::: "memory");
                { float wc2[64];
#pragma unroll
                  for (int i = 0; i < 64; ++i) wc2[i] = w2[i * 64 + lane];
                  for (int p = 0; p < 32; ++p) { float a = bb2;
#pragma unroll
                      for (int i4 = 0; i4 < 16; ++i4) { const f32x4 hv = *(const LAS f32x4*)(hh + p * 68 + 4 * i4); a = fmaf(hv[0], wc2[4 * i4], a); a = fmaf(hv[1], wc2[4 * i4 + 1], a); a = fmaf(hv[2], wc2[4 * i4 + 2], a); a = fmaf(hv[3], wc2[4 * i4 + 3], a); }
                      const float h2v = __builtin_amdgcn_sinf(fr * a);
                      asm volatile("s_waitcnt lgkmcnt(0)" ::: "memory");
                      hh[p * 68 + lane] = h2v; } }
                LDS_WAIT(); asm volatile("" ::: "memory");
                const int n = lane & 31, kh = lane >> 5;
                bf16x8 Af[4];
#pragma unroll
                for (int ks = 0; ks < 4; ++ks) { const f32x4 x0 = *(const LAS f32x4*)(hh + n * 68 + 16 * ks + 8 * kh), x1 = *(const LAS f32x4*)(hh + n * 68 + 16 * ks + 8 * kh + 4);
                    u32x4 w; w.x = cvt_pk_bf16(x0[0], x0[1]); w.y = cvt_pk_bf16(x0[2], x0[3]); w.z = cvt_pk_bf16(x1[0], x1[1]); w.w = cvt_pk_bf16(x1[2], x1[3]); Af[ks] = __builtin_bit_cast(bf16x8, w); }
                const float invL = 1.0f / (float)L;
                for (int nt = 0; nt < 16; ++nt) {
                    const int col = cb * 512 + nt * 32 + n; const float* wp = w3 + (size_t)(8 * kh) * 4096 + col;
                    f32x16 acc = f32x16{};
#pragma unroll
                    for (int ks = 0; ks < 4; ++ks) { float wv[8];
#pragma unroll
                        for (int e = 0; e < 8; ++e) wv[e] = wp[(size_t)(16 * ks + e) * 4096];
                        u32x4 w; w.x = cvt_pk_bf16(wv[0], wv[1]); w.y = cvt_pk_bf16(wv[2], wv[3]); w.z = cvt_pk_bf16(wv[4], wv[5]); w.w = cvt_pk_bf16(wv[6], wv[7]);
                        acc = __builtin_amdgcn_mfma_f32_32x32x16_bf16(Af[ks], __builtin_bit_cast(bf16x8, w), acc, 0, 0, 0); }
                    const float bias = b3[col]; const float dl = fabsf(HY_MIN_DECAY + (float)(col & 1023) * ((HY_MAX_DECAY - HY_MIN_DECAY) / 1023.0f)) * 1.4426950408889634f;
                    float* hr = HRAW + ((size_t)l * 2304 + chunk * 32) * 4096 + col; float ps = 0.f;
#pragma unroll
                    for (int rr = 0; rr < 16; ++rr) { const int prow = (rr & 3) + 8 * (rr >> 2) + 4 * kh; const float t = (float)(p0 + prow) * invL;
                        const float v = (acc[rr] + bias) * __builtin_amdgcn_exp2f(-t * dl); ps += fabsf(v); hr[(size_t)prow * 4096] = v; }
                    { auto sw = __builtin_amdgcn_permlane32_swap(__float_as_uint(ps), __float_as_uint(ps), false, false); ps = __uint_as_float(sw[0]) + __uint_as_float(sw[1]); }
                    if (lane < 32) PART[((size_t)l * 72 + chunk) * 4096 + col] = ps;
                }
                LDS_WAIT(); asm volatile("" ::: "memory");
            }
        }
        for (int i = gt; i < 512 * 256; i += NGT) { const int r = i >> 8, c = i & 255; const int j = r & 255; const int mm = (j * c) & 255; const float a = 2.0f * (float)mm / 256.0f;
            CS[i] = f2bf((r < 256 ? cospif(a) : sinpif(a)) * 0.0625f); }
        for (int i = gt; i < 256 * 512; i += NGT) { const int t = i >> 9, s = i & 511; const int mm = (t * (s & 255)) & 255; const float a = 2.0f * (float)mm / 256.0f;
            FL256[i] = f2bf((s < 256 ? cospif(a) : -sinpif(a)) * 0.0625f); }
        { LAS unsigned* tw = (LAS unsigned*)(ldsp + RING_BYTES + 1024);
          __syncthreads();
          for (int m = wave * 64 + lane; m < 2048; m += NWAVES * 64) { const float a = 2.0f * (float)m / 2048.0f; tw[m] = cvt_pk_bf16(cospif(a) * 0.022097086912079608f, -sinpif(a) * 0.022097086912079608f); }
          __syncthreads();
          for (int i = gt; i < 2048 * 512; i += NGT) { const int t = i >> 9, s0 = (i & 511) * 8; const int hs = s0 >> 11; unsigned e[8];
#pragma unroll
              for (int k = 0; k < 8; ++k) { const unsigned w = tw[(t * ((s0 + k) & 2047)) & 2047]; e[k] = hs ? (w >> 16) : (w & 0xffffu); }
              u32x4 o; o.x = e[0] | (e[1] << 16); o.y = e[2] | (e[3] << 16); o.z = e[4] | (e[5] << 16); o.w = e[6] | (e[7] << 16);
              *(u32x4*)(FL2048 + (size_t)i * 8) = o; }
        }
    }
    SEAM(0);
    if (EN(1) && IN(1)) { PHASE_LOCALS
        for (int i = gt; i < 2 * 3 * 12288; i += NGT) { const int l = i / 36864, r = (i % 36864) / 12288, n = i % 12288;
            float a = karg[I_BMOD][l * 12288 + n];
            for (int kc = 0; kc < 32; ++kc) a += MODP[((size_t)(l * 32 + kc) * 3 + r) * 12288 + n];
            MOD[i] = a; }
        for (int i = gt; i < 8 * 8192; i += NGT) { const int j = i & 8191, sl = i >> 13; const int c = j & 1023, o = (j >> 10) & 1, Lsel = (j >> 11) & 1, l = j >> 12;
            const int c0 = (Lsel ? 8 : 0) + sl, c1 = Lsel ? 72 : 8; float s = 0.f;
#pragma unroll
            for (int k = 0; k < 8; ++k) { const int ch = c0 + 8 * k; if (ch < c1) { const float* p = PART + ((size_t)l * 72 + ch) * 4096 + o * 2048 + c; s += p[0] + p[1024]; } }
            INVN[i] = s; }
    }
    SEAM(1);
    if (EN(2) && IN(2)) { PHASE_LOCALS
        for (int it = gw; it < 2 * 2304; it += NGW) {
            const int l = it / 2304; int r = it % 2304; int Lsel, L;
            if (r < 256) { Lsel = 0; L = 256; } else { Lsel = 1; L = 2048; r -= 256; }
            const int nqb = (2 * L) / 64; const int o = r / (nqb * 16), qb = (r / 16) % nqb, cb = r % 16; const int c = cb * 64 + lane;
            float nsum = EPS;
#pragma unroll
            for (int sl = 0; sl < 8; ++sl) nsum += INVN[sl * 8192 + ((l * 2 + Lsel) * 2 + o) * 1024 + c];
            const float inv = 1.0f / nsum;
            const float* hb = HRAW + ((size_t)l * 2304 + (Lsel ? 256 : 0)) * 4096 + o * 2048 + c;
            const float bias = karg[I_HBIAS][(l * 2 + o) * 1024 + c];
            bf16_t* dst = RVT + (size_t)l * hy::RV_PER_LAYER + (Lsel ? (size_t)2 * 1024 * 512 : 0) + ((size_t)o * 1024 + c) * (2 * L) + qb * 64;
#pragma unroll
            for (int j8 = 0; j8 < 8; ++j8) { float v[8];
#pragma unroll
                for (int e = 0; e < 8; ++e) { const int q = qb * 64 + j8 * 8 + e; const int d = L - 1 - q;
                    float x = 0.f;
                    if (q < 2 * L - 1) { if (d > 0) x = hb[(size_t)d * 4096] * inv; else if (d < 0) x = hb[(size_t)(-d) * 4096 + 1024] * inv; else x = (hb[0] + hb[1024]) * inv + bias; }
                    v[e] = x; }
                u32x4 w; w.x = cvt_pk_bf16(v[0], v[1]); w.y = cvt_pk_bf16(v[2], v[3]); w.z = cvt_pk_bf16(v[4], v[5]); w.w = cvt_pk_bf16(v[6], v[7]);
                *(u32x4*)(dst + j8 * 8) = w; }
        }
        for (int m = gw; m < MTOK; m += NGW) {
            const float* xr = (m < M_CTX) ? x_prompt + (size_t)m * DM : x_sample + (size_t)(m - M_CTX) * DM;
            const int r = (m < M_CTX) ? 0 : 1 + (m - M_CTX) / L_LAT;
            f32x4 v[16];
#pragma unroll
            for (int j = 0; j < 16; ++j) v[j] = __builtin_nontemporal_load((const f32x4*)(xr + 4 * lane + 256 * j));
            prenorm_store(v, karg[I_GPRE], MOD + (size_t)r * 12288, Hb + (size_t)m * DM, H8 + (size_t)m * DM, lane);
        }
    }
    SEAM(2);

    for (int l = 0; l < 2; ++l) {
        const int pb = 3 + 7 * l;
        if (EN(3) && IN(pb + 0)) { PHASE_LOCALS
            const pg8::EpiProj E{PROJ, Qb, KC, VC, KL, VL, URC, URL, out_k, out_v, (LAS float*)(ldsp + RING_BYTES + 1024), l};
            { LAS float* gl = (LAS float*)(ldsp + RING_BYTES + 1024) + 2048; const int t_ = wave * 64 + lane; if (t_ < 256) gl[t_] = (t_ < 128 ? karg[I_QN] + l * 128 : karg[I_KN] + l * 128 - 128)[t_]; }
            __syncthreads();
            const unsigned xq = bar.x & 7u; LAS unsigned* qsl = (LAS unsigned*)(ldsp + RING_BYTES + 16);
            { struct Sched { enum { DYN = 1 }; LAS unsigned* qs; unsigned* ctr0; unsigned x0; const char* A; const char* B; unsigned cnt;
                __device__ __forceinline__ unsigned draw(unsigned q) const { return __hip_atomic_fetch_add(ctr0 + q * 64, 1u, __ATOMIC_RELAXED, __HIP_MEMORY_SCOPE_AGENT); }
                __device__ __forceinline__ unsigned resolve(unsigned off, unsigned q, unsigned& qcur) const { for (int k = 0; k < 8; ++k) { if (off < cnt) return q * cnt + off; q = (q + 1u) & 7u; qcur = q; off = draw(q); } return ~0u; }
                __device__ __forceinline__ bool next(int i, pg8::Unit& u) const { const int id = __builtin_amdgcn_readfirstlane((int)qs[i & 1]); if (id < 0) return false; int pm, pn; pg8::tile_of_id(id, 48, 8, pm, pn);
                    u.a = A + (size_t)pm * 256 * DM; u.b = B + (size_t)pn * 256 * DM; u.K = DM / 2; u.pm = pm; u.pn = pn; u.aux = 0; return true; } };
              const Sched S{qsl, ctl + CW_Q + ((l * 8 + 3) * 8) * 64, xq, (const char*)H8, (const char*)(WIN8 + (size_t)l * N8 * DM), 48u};
              pg8::gemm_phase<1, true>(ldsp, pg8::Gemm{DM / 2, DM / 2}, S, E, wave); }
            { struct Sched { enum { DYN = 1 }; LAS unsigned* qs; unsigned* ctr0; unsigned x0; const char* A; const char* B; unsigned cnt;
                __device__ __forceinline__ unsigned draw(unsigned q) const { return __hip_atomic_fetch_add(ctr0 + q * 64, 1u, __ATOMIC_RELAXED, __HIP_MEMORY_SCOPE_AGENT); }
                __device__ __forceinline__ unsigned resolve(unsigned off, unsigned q, unsigned& qcur) const { for (int k = 0; k < 8; ++k) { if (off < cnt) return q * cnt + off; q = (q + 1u) & 7u; qcur = q; off = draw(q); } return ~0u; }
                __device__ __forceinline__ bool next(int i, pg8::Unit& u) const { const int id = __builtin_amdgcn_readfirstlane((int)qs[i & 1]); if (id < 0) return false; int pm, pn; pg8::tile_of_id(id, 48, 2, pm, pn); pn += 8;
                    u.a = A + (size_t)pm * 256 * DM * 2; u.b = B + (size_t)pn * 256 * DM * 2; u.K = DM; u.pm = pm; u.pn = pn; u.aux = 0; return true; } };
              const Sched S{qsl, ctl + CW_Q + ((l * 8 + 0) * 8) * 64, xq, (const char*)Hb, (const char*)(WIN + (size_t)l * INW * DM), 12u};
              pg8::gemm_phase<1, false>(ldsp, pg8::Gemm{DM, DM}, S, E, wave); }
            { struct Sched { enum { DYN = 1 }; LAS unsigned* qs; unsigned* ctr0; unsigned x0; const char* A; const char* B; unsigned cnt;
                __device__ __forceinline__ unsigned draw(unsigned q) const { return __hip_atomic_fetch_add(ctr0 + q * 64, 1u, __ATOMIC_RELAXED, __HIP_MEMORY_SCOPE_AGENT); }
                __device__ __forceinline__ unsigned resolve(unsigned off, unsigned q, unsigned& qcur) const { for (int k = 0; k < 8; ++k) { if (off < cnt) return q * cnt + off; q = (q + 1u) & 7u; qcur = q; off = draw(q); } return ~0u; }
                __device__ __forceinline__ bool next(int i, pg8::Unit& u) const { const int id = __builtin_amdgcn_readfirstlane((int)qs[i & 1]); if (id < 0) return false; int pm, pn; pg8::tile_of_id(id, 48, 10, pm, pn); pn = pn < 2 ? pn + 10 : pn + 18;
                    const char* ta = A + (size_t)pm * 256 * DM * 2; const char* tb = B + (size_t)pn * 256 * DM * 2; const bool swp = (pn >= 28 && pn < 40);
                    u.a = swp ? tb : ta; u.b = swp ? ta : tb; u.K = DM; u.pm = pm; u.pn = pn; u.aux = 0; return true; } };
              const Sched S{qsl, ctl + CW_Q + ((l * 8 + 1) * 8) * 64, xq, (const char*)Hb, (const char*)(WIN + (size_t)l * INW * DM), 60u};
              pg8::gemm_phase<0, false>(ldsp, pg8::Gemm{DM, DM}, S, pg8::EpiRest{PROJ, VC, VL, URC, URL, out_v, l}, wave); }
            { struct Sched { enum { DYN = 1 }; LAS unsigned* qs; unsigned* ctr0; unsigned x0; const char* A; const char* B; unsigned cnt;
                __device__ __forceinline__ unsigned draw(unsigned q) const { return __hip_atomic_fetch_add(ctr0 + q * 64, 1u, __ATOMIC_RELAXED, __HIP_MEMORY_SCOPE_AGENT); }
                __device__ __forceinline__ unsigned resolve(unsigned off, unsigned q, unsigned& qcur) const { for (int k = 0; k < 8; ++k) { if (off < cnt) return q * cnt + off; q = (q + 1u) & 7u; qcur = q; off = draw(q); } return ~0u; }
                __device__ __forceinline__ bool next(int i, pg8::Unit& u) const { const int id = __builtin_amdgcn_readfirstlane((int)qs[i & 1]); if (id < 0) return false; int pm, pn; pg8::tile_of_id(id, 48, 24, pm, pn);
                    const char* ta = A + (size_t)pm * 256 * DM; const char* tb = B + (size_t)(pn + 8) * 256 * DM; pn = pn < 8 ? pn + 12 : pn + 20;
                    const bool swp = (pn >= 28 && pn < 40);
                    u.a = swp ? tb : ta; u.b = swp ? ta : tb; u.K = DM / 2; u.pm = pm; u.pn = pn; u.aux = 0; return true; } };
              const Sched S{qsl, ctl + CW_Q + ((l * 8 + 2) * 8) * 64, xq, (const char*)H8, (const char*)(WIN8 + (size_t)l * N8 * DM), 144u};
              pg8::gemm_phase<0, true>(ldsp, pg8::Gemm{DM / 2, DM / 2}, S, pg8::EpiSig{PROJ, URC, URL}, wave); }
            { struct Sched { enum { DYN = 1 }; LAS unsigned* qs; unsigned* ctr0; unsigned x0; const char* A; const char* B; unsigned cnt;
                __device__ __forceinline__ unsigned draw(unsigned q) const { return __hip_atomic_fetch_add(ctr0 + q * 64, 1u, __ATOMIC_RELAXED, __HIP_MEMORY_SCOPE_AGENT); }
                __device__ __forceinline__ unsigned resolve(unsigned off, unsigned q, unsigned& qcur) const { for (int k = 0; k < 8; ++k) { if (off < cnt) return q * cnt + off; q = (q + 1u) & 7u; qcur = q; off = draw(q); } return ~0u; }
                __device__ __forceinline__ bool next(int i, pg8::Unit& u) const { const int id = __builtin_amdgcn_readfirstlane((int)qs[i & 1]); if (id < 0) return false; int pm, pn; pg8::tile_of_id(id, 48, 16, pm, pn);
                    u.a = A + (size_t)pm * 256 * DM; u.b = B + (size_t)(pn + 48) * 256 * DM; u.K = DM / 2; u.pm = pm; u.pn = pn + 60; u.aux = 0; return true; } };
              const Sched S{qsl, ctl + CW_Q + ((l * 8 + 4) * 8) * 64, xq, (const char*)H8, (const char*)(WIN8 + (size_t)l * N8 * DM), 96u};
              pg8::gemm_phase<0, true>(ldsp, pg8::Gemm{DM / 2, DM / 2}, S, pg8::EpiT{PROJ}, wave); }
            { struct Sched { enum { DYN = 1 }; LAS unsigned* qs; unsigned* ctr0; unsigned x0; const char* A; const char* B; unsigned cnt;
                __device__ __forceinline__ unsigned draw(unsigned q) const { return __hip_atomic_fetch_add(ctr0 + q * 64, 1u, __ATOMIC_RELAXED, __HIP_MEMORY_SCOPE_AGENT); }
                __device__ __forceinline__ unsigned resolve(unsigned off, unsigned q, unsigned& qcur) const { for (int k = 0; k < 8; ++k) { if (off < cnt) return q * cnt + off; q = (q + 1u) & 7u; qcur = q; off = draw(q); } return ~0u; }
                __device__ __forceinline__ bool next(int i, pg8::Unit& u) const { const int id = __builtin_amdgcn_readfirstlane((int)qs[i & 1]); if (id < 0) return false; int pm, pn; pg8::tile_of_id(id, 48, 32, pm, pn);
                    const int gt = pn < 16 ? pn : pn + 16;
                    u.a = A + (size_t)pm * 256 * DM; u.b = B + (size_t)(gt + 32) * 256 * DM; u.K = DM / 2; u.pm = pm; u.pn = gt + 44; u.aux = 0; return true; } };
              const Sched S{qsl, ctl + CW_Q + ((l * 8 + 5) * 8) * 64, xq, (const char*)H8, (const char*)(WIN8 + (size_t)l * N8 * DM), 192u};
              pg8::gemm_phase<0, true>(ldsp, pg8::Gemm{DM / 2, DM / 2}, S, pg8::EpiT8{PROJ}, wave); }
        }
        SEAM(pb + 0);
        if (EN(4) && IN(pb + 1)) { PHASE_LOCALS
            for (int i = gt; i < 2 * PAST * 512; i += NGT) { const int b = i / (PAST * 512), r = i % (PAST * 512);
                const size_t src = ((size_t)(b * 2 + l) * PAST) * 512 + r; const size_t dst = ((size_t)b * KV_LAT + L_LAT) * 512 + r;
                KL[dst] = f2bf(karg[I_CK][src]); VL[dst] = f2bf(karg[I_CV][src]); }
            __syncthreads();
            if (SUB(2)) {
                struct Sched { enum { DYN = 0 }; LAS unsigned* qs; unsigned* ctr0; unsigned x0; __device__ __forceinline__ unsigned draw(unsigned) const { return 0u; } __device__ __forceinline__ unsigned resolve(unsigned, unsigned, unsigned&) const { return 0u; } const char* A; const char* B; int G, c, K;
                    __device__ __forceinline__ bool next(int i, pg8::Unit& u) const { const int L = i * G + c; if (L >= 384) return false; const int tt = L >> 3, g = (L >> 1) & 3, pm = L & 1;
                        u.a = A + (size_t)pm * 256 * 256 * 2; u.b = B + ((size_t)tt * 256 * INW + C_FIN + g * 256) * 2; u.K = K; u.pm = pm; u.pn = tt; u.aux = g; return true; } };
                const int k256 = 256;
                const Sched S{nullptr, nullptr, 0u, (const char*)CS, (const char*)PROJ, G, bx, k256};
                pg8::gemm_phase(ldsp, pg8::Gemm{256, INW}, S, pg8::EpiChan{UCSC, UCSL}, wave);
            }
        }
        SEAM(pb + 1);
        if (EN(5) && IN(pb + 2)) { PHASE_LOCALS
            if (SUB(3)) for (int ui = bx; ui < 768; ui += G) {
                if (ui < 256) { const int b = ui >> 7, h = (ui >> 3) & 15, qb = ui & 7; const size_t row0 = (size_t)M_CTX + b * L_LAT + qb * 256;
                    att::attn_dense_body((const bf16_t*)((const char*)Qb + row0 * 2048 + h * 128), KL + (size_t)b * KV_LAT * 512 + (h >> 2) * 128, VL + (size_t)b * KV_LAT * 512 + (h >> 2) * 128,
                                         (bf16_t*)((char*)(BR + row0 * DM) + h * 128), (const bf16_t*)((const char*)PROJ + row0 * INW * 2 + 2 * C_AG + h * 128), KV_LAT, (char*)lds, wave); }
                else { const int q = ui - 256, b = q >> 4, h = q & 15; const size_t row0 = (size_t)b * L_CTX;
                    att::attn_dense_body((const bf16_t*)((const char*)Qb + row0 * 2048 + h * 128), KC + row0 * 512 + (h >> 2) * 128, VC + row0 * 512 + (h >> 2) * 128,
                                         (bf16_t*)((char*)(BR + row0 * DM) + h * 128), (const bf16_t*)((const char*)PROJ + row0 * INW * 2 + 2 * C_AG + h * 128), L_CTX, (char*)lds, wave); }
            }
            __syncthreads();
            if (SUB(4)) {
                struct Sched { enum { DYN = 0 }; LAS unsigned* qs; unsigned* ctr0; unsigned x0; __device__ __forceinline__ unsigned draw(unsigned) const { return 0u; } __device__ __forceinline__ unsigned resolve(unsigned, unsigned, unsigned&) const { return 0u; } const char* A; const char* B; int G, c;
                    __device__ __forceinline__ bool next(int i, pg8::Unit& u) const { const int L = i * G + c; if (L >= 128) return false; const int sq = L >> 2, pn = L & 3;
                        u.a = A; u.b = B + ((size_t)sq * 1024 + pn * 256) * 512 * 2; u.K = 512; u.pm = sq; u.pn = pn; u.aux = sq * 256; return true; } };
                const Sched S{nullptr, nullptr, 0u, (const char*)FL256, (const char*)UCSC, G, bx};
                pg8::gemm_phase(ldsp, pg8::Gemm{512, 512}, S, pg8::EpiGate{BR, PROJ}, wave);
            }
            if (SUB(5)) {
                struct Sched { enum { DYN = 0 }; LAS unsigned* qs; unsigned* ctr0; unsigned x0; __device__ __forceinline__ unsigned draw(unsigned) const { return 0u; } __device__ __forceinline__ unsigned resolve(unsigned, unsigned, unsigned&) const { return 0u; } const char* A; const char* B; int G, c;
                    __device__ __forceinline__ bool next(int i, pg8::Unit& u) const { const int L = i * G + c; if (L >= 256) return false; const int ks = L & 3, pn = (L >> 2) & 3, pm = (L >> 4) & 7, sq = L >> 7;
                        u.a = A + ((size_t)pm * 256 * 4096 + ks * 1024) * 2; u.b = B + (((size_t)sq * 1024 + pn * 256) * 4096 + ks * 1024) * 2; u.K = 1024; u.pm = sq * 8 + pm; u.pn = pn; u.aux = ks; return true; } };
                const Sched S{nullptr, nullptr, 0u, (const char*)FL2048, (const char*)UCSL, G, bx};
                pg8::gemm_phase(ldsp, pg8::Gemm{4096, 4096}, S, pg8::EpiPart{FNP}, wave);
            }
            if (SUB(6)) {
                const bf16_t* rvl = RVT + (size_t)l * hy::RV_PER_LAYER; const float* hsw = karg[I_HSW] + (size_t)l * 3 * 3072; const float* hsb = karg[I_HSB] + (size_t)l * 3072;
                if (wave < 4) { LAS unsigned char* lw = ldsp + wave * hy::LAT_LDS;
                    for (int c = bx * 4 + wave; c < 1024; c += G * 4) hy::lat_task(lw, rvl + (size_t)2 * 1024 * 512 + (size_t)c * 4096, (const unsigned char*)URL + (size_t)c * 2048, Y2L + (size_t)c * 2048, hsw, hsb, c, lane); }
                else { LAS unsigned char* lw = ldsp + 4 * hy::LAT_LDS + (wave - 4) * 2048;
                    for (int c = bx * 4 + (wave - 4); c < 1024; c += G * 4) hy::ctx_task(lw, rvl + (size_t)c * 512, (const unsigned char*)URC + (size_t)c * 256, Y2C + (size_t)c * 256, hsw, hsb, c, lane); }
            }
        }
        SEAM(pb + 2);
        if (EN(6) && IN(pb + 3)) { PHASE_LOCALS
            for (int it = gw; it < 2048 + 1024; it += NGW) {
                int sq, pbk, cb, L; size_t row0; const bf16_t* y2;
                if (it < 2048) { sq = it >> 6; pbk = (it >> 4) & 3; cb = it & 15; L = L_CTX; row0 = (size_t)sq * L_CTX; y2 = Y2C + (size_t)sq * 1024 * 256; }
                else { const int q = it - 2048; sq = q >> 9; pbk = (q >> 4) & 31; cb = q & 15; L = L_LAT; row0 = (size_t)M_CTX + (size_t)sq * L_LAT; y2 = Y2L + (size_t)sq * 1024 * 2048; }
                const int pp = lane & 31, chh = lane >> 5, t0 = pbk * 64 + 2 * pp; const bf16_t* src = y2 + (size_t)(cb * 64 + chh * 32) * L + t0;
                const unsigned char* gp = (const unsigned char*)PROJ + (row0 + t0) * INW * 2 + 2 * C_HG + cb * 64 + chh * 32; unsigned char* dst = (unsigned char*)(BR + (row0 + t0) * DM) + 6144 + cb * 64 + chh * 32;
                unsigned raw[32];
#pragma unroll
                for (int c = 0; c < 32; ++c) raw[c] = *(const unsigned*)(src + (size_t)c * L);
#pragma unroll
                for (int q = 0; q < 2; ++q) { const u32x4 g0 = *(const u32x4*)(gp + (size_t)q * INW * 2), g1 = *(const u32x4*)(gp + (size_t)q * INW * 2 + 16); u32x4 o0, o1;
#pragma unroll
                    for (int c4 = 0; c4 < 8; ++c4) { const int gw_ = (int)(c4 < 4 ? g0[c4] : g1[c4 - 4]); float y[4];
#pragma unroll
                        for (int e = 0; e < 4; ++e) y[e] = bf2f(q ? (raw[4 * c4 + e] >> 16) : (raw[4 * c4 + e] & 0xffffu)) * 64.f;
                        const unsigned w = pk_fp8x4(y[0] * __builtin_amdgcn_cvt_f32_fp8(gw_, 0), y[1] * __builtin_amdgcn_cvt_f32_fp8(gw_, 1), y[2] * __builtin_amdgcn_cvt_f32_fp8(gw_, 2), y[3] * __builtin_amdgcn_cvt_f32_fp8(gw_, 3));
                        if (c4 < 4) o0[c4] = w; else o1[c4 - 4] = w; }
                    *(u32x4*)(dst + (size_t)q * DM * 2) = o0; *(u32x4*)(dst + (size_t)q * DM * 2 + 16) = o1; }
            }
            for (int i = gt; i < M_LAT * 1024 / 8; i += NGT) { const int r = i >> 7, c = (i & 127) * 8; const size_t row = (size_t)M_CTX + r;
                f32x4 a0 = {0.f, 0.f, 0.f, 0.f}, a1 = a0;
#pragma unroll
                for (int ks = 0; ks < 4; ++ks) { const bf16_t* p = (const bf16_t*)FNP + ((size_t)ks * M_LAT + r) * 1024 + c; f32x4 p0, p1; pg8::unpack8(__builtin_nontemporal_load((const u32x4*)p), p0, p1); a0 += p0; a1 += p1; }
                f32x4 g0, g1; pg8::unpack8(*(const u32x4*)(PROJ + row * INW + C_FG + c), g0, g1);
                *(u32x4*)(BR + row * DM + 2048 + c) = pg8::pack8(a0 * g0, a1 * g1); }
        }
        SEAM(pb + 3);
        if (EN(7) && IN(pb + 4)) { PHASE_LOCALS
            struct Sched { enum { DYN = 0 }; LAS unsigned* qs; unsigned* ctr0; unsigned x0; __device__ __forceinline__ unsigned draw(unsigned) const { return 0u; } __device__ __forceinline__ unsigned resolve(unsigned, unsigned, unsigned&) const { return 0u; } const char* A; const char* B; int G, c;
                __device__ __forceinline__ bool next(int i, pg8::Unit& u) const { const int ti = i / 3, seg = i % 3; const int L = ti * G + c; if (L >= 48 * 16) return false; int pm, pn; pg8::tile_of(L, 48, 16, pm, pn);
                    const int koff = seg == 0 ? 0 : (seg == 1 ? 4096 : 6144);
                    u.a = A + (size_t)pm * 256 * DM * 2 + koff; u.b = B + (size_t)pn * 256 * DM * 2 + koff; u.K = seg == 2 ? 512 : 1024; u.pm = pm; u.pn = pn; u.aux = seg; u.f8 = seg != 1; return true; } };
            const Sched S{nullptr, nullptr, 0u, (const char*)BR, (const char*)(WM + (size_t)l * DM * DM), G, bx};
            pg8::gemm_phase<0, 2>(ldsp, pg8::Gemm{DM, DM}, S, pg8::EpiMerge{MG, PROJ}, wave);
        }
        SEAM(pb + 4);
        if (EN(8) && IN(pb + 5)) { PHASE_LOCALS
            struct Sched { enum { DYN = 0 }; LAS unsigned* qs; unsigned* ctr0; unsigned x0; __device__ __forceinline__ unsigned draw(unsigned) const { return 0u; } __device__ __forceinline__ unsigned resolve(unsigned, unsigned, unsigned&) const { return 0u; } const char* A; const char* B; int G, c;
                __device__ __forceinline__ bool next(int i, pg8::Unit& u) const { const int L = i * G + c; if (L >= 48 * 16) return false; int pm, pn; pg8::tile_of(L, 48, 16, pm, pn);
                    u.a = A + (size_t)pm * 256 * DM * 2; u.b = B + (size_t)pn * 256 * DM * 2; u.K = DM; u.pm = pm; u.pn = pn; u.aux = 0; return true; } };
            const Sched S{nullptr, nullptr, 0u, (const char*)MG, (const char*)(WO + (size_t)l * DM * DM), G, bx};
            pg8::gemm_phase(ldsp, pg8::Gemm{DM, DM}, S, pg8::EpiO16{(bf16_t*)Ob}, wave);
        }
        SEAM(pb + 5);
        if (EN(9) && IN(pb + 6)) { PHASE_LOCALS
            const float* gpost = karg[I_GPOST] + (size_t)l * DM;
            for (int m = gw; m < MTOK; m += NGW) {
                const int r = (m < M_CTX) ? 0 : 1 + (m - M_CTX) / L_LAT;
                const float* xin = (l == 0) ? ((m < M_CTX) ? x_prompt + (size_t)m * DM : x_sample + (size_t)(m - M_CTX) * DM) : X1 + (size_t)m * DM;
                const bf16_t* orow = (const bf16_t*)Ob + (size_t)m * DM; const float* gate = MOD + ((size_t)l * 3 + r) * 12288 + 2 * DM;
                float* xo = (l == 0) ? X1 + (size_t)m * DM : out + (size_t)m * DM;
                f32x4 v[16]; float ss = 0.f;
#pragma unroll
                for (int j = 0; j < 16; ++j) { v[j] = hy::bf4(__builtin_nontemporal_load((const u32x2*)(orow + 4 * lane + 256 * j))); ss += (v[j].x * v[j].x + v[j].y * v[j].y) + (v[j].z * v[j].z + v[j].w * v[j].w); }
                const float rs = 1.0f / sqrtf(wave_sum(ss) * (1.f / DM) + EPS);
#pragma unroll
                for (int j = 0; j < 16; ++j) { const int c = 4 * lane + 256 * j;
                    const f32x4 y = __builtin_nontemporal_load((const f32x4*)(xin + c)) + *(const f32x4*)(gate + c) * ((v[j] * rs) * *(const f32x4*)(gpost + c));
                    __builtin_nontemporal_store(y, (f32x4*)(xo + c)); v[j] = y; }
                if (l == 0) prenorm_store(v, karg[I_GPRE] + DM, MOD + ((size_t)3 + r) * 12288, Hb + (size_t)m * DM, H8 + (size_t)m * DM, lane);
            }
        }
        SEAM(pb + 6);
    }
#undef IN
#undef SEAM
#undef GRID_BAR
}

extern "C" void kernel_launch(void* const* d_in, const int* in_sizes, int n_in, void* d_out, int out_size, void* d_ws, size_t ws_size, hipStream_t stream) {
    static int grid = 0;
    if (grid == 0) {
        if (n_in != 27 || ws_size < WS_END) { fprintf(stderr, "kernel_launch: expected 27 inputs and >= %zu bytes of workspace (got %d, %zu)\n", (size_t)WS_END, n_in, ws_size); grid = -1; return; }
        int dev = 0, cus = 0, per_cu = 0;
        if (hipGetDevice(&dev) != hipSuccess || hipDeviceGetAttribute(&cus, hipDeviceAttributeMultiprocessorCount, dev) != hipSuccess) { grid = -1; return; }
        if (hipFuncSetAttribute((const void*)mega_fwd, hipFuncAttributeMaxDynamicSharedMemorySize, LDS_BYTES) != hipSuccess) { fprintf(stderr, "kernel_launch: hipFuncSetAttribute failed\n"); grid = -1; return; }
        if (hipOccupancyMaxActiveBlocksPerMultiprocessor(&per_cu, (const void*)mega_fwd, NWAVES * 64, LDS_BYTES) != hipSuccess || per_cu < 1)
            fprintf(stderr, "kernel_launch: occupancy query reports %d workgroups per CU\n", per_cu);
        (void)hipGetLastError();
        grid = cus;
    }
    if (grid < 0) return;
    (void)hipMemsetAsync((char*)d_ws + WS_CTL, 0, CTL_ZERO_BYTES, stream);
    Args a{};
    for (int i = 0; i < 27; ++i) a.in[i] = (const float*)d_in[i];
    a.out = (float*)d_out; a.ws = (unsigned char*)d_ws;
#if MK_PER_PHASE
    for (int p = 0; p < N_PHASES; ++p) { a.ph_lo = p; a.ph_hi = p + 1; hipLaunchKernelGGL(mega_fwd, dim3(grid), dim3(NWAVES * 64), LDS_BYTES, stream, a); }
#else
    a.ph_lo = 0; a.ph_hi = N_PHASES;
    hipLaunchKernelGGL(mega_fwd, dim3(grid), dim3(NWAVES * 64), LDS_BYTES, stream, a);
#endif
    const hipError_t le = hipPeekAtLastError();
    if (le != hipSuccess) fprintf(stderr, "kernel_launch: launch failed: %s\n", hipGetErrorName(le));
}
```

```cpp
#include <hip/hip_runtime.h>
#include <hip/hip_bf16.h>
#include <cstdio>
#include <cstdint>

#ifndef MK_PER_PHASE
#define MK_PER_PHASE 0
#endif

constexpr int DM = 4096, M_CTX = 8192, M_LAT = 4096, MTOK = 12288;
constexpr int L_CTX = 256, L_LAT = 2048, PAST = 512, KV_LAT = 2560;
constexpr int INW = 23552;
constexpr int C_K = 2048, C_V = 2560, C_AG = 3072, C_FIN = 5120, C_FG = 6144, C_HV = 7168, C_HG = 10240, C_GA = 11264;
constexpr float EPS = 1e-6f;

constexpr size_t MiB = 1u << 20;
constexpr size_t al(size_t x) { return (x + MiB - 1) / MiB * MiB; }
constexpr size_t WS_CTL = 0, CTL_ZERO_BYTES = MiB;
constexpr size_t WS_WIN = MiB;
constexpr size_t WS_WM = WS_WIN + al((size_t)2 * INW * DM * 2);
constexpr size_t WS_WO = WS_WM + al((size_t)2 * DM * DM * 2);
constexpr size_t WS_H = WS_WO + al((size_t)2 * DM * DM * 2);
constexpr size_t WS_PROJ = WS_H + al((size_t)MTOK * DM * 2);
constexpr size_t WS_QKV = WS_PROJ + al((size_t)MTOK * INW * 2);
constexpr size_t WS_Q = WS_QKV + al((size_t)MTOK * 3072 * 4);
constexpr size_t WS_KC = WS_Q + al((size_t)MTOK * 2048 * 2);
constexpr size_t WS_VC = WS_KC + al((size_t)M_CTX * 512 * 2);
constexpr size_t WS_KL = WS_VC + al((size_t)M_CTX * 512 * 2);
constexpr size_t WS_VL = WS_KL + al((size_t)2 * KV_LAT * 512 * 2);
constexpr size_t WS_BR = WS_VL + al((size_t)2 * KV_LAT * 512 * 2);
constexpr size_t WS_UCSC = WS_BR + al((size_t)MTOK * DM * 2);
constexpr size_t WS_UCSL = WS_UCSC + al((size_t)32 * 1024 * 512 * 2);
constexpr size_t WS_U = WS_UCSL + al((size_t)2 * 1024 * 4096 * 2);
constexpr size_t WS_Z1 = WS_U + al((size_t)MTOK * 3072 * 4);
constexpr size_t WS_P = WS_Z1 + al((size_t)MTOK * 1024 * 4);
constexpr size_t WS_MG = WS_P + al((size_t)MTOK * DM * 4);
constexpr size_t WS_O = WS_MG + al((size_t)MTOK * DM * 2);
constexpr size_t WS_X1 = WS_O + al((size_t)MTOK * DM * 4);
constexpr size_t WS_MODP = WS_X1 + al((size_t)MTOK * DM * 4);
constexpr size_t WS_MOD = WS_MODP + al((size_t)2 * 32 * 3 * 12288 * 4);
constexpr size_t WS_HRAW = WS_MOD + al((size_t)2 * 3 * 12288 * 4);
constexpr size_t WS_PART = WS_HRAW + al((size_t)2 * 2304 * 4096 * 4);
constexpr size_t WS_INVN = WS_PART + al((size_t)2 * 144 * 4096 * 4);
constexpr size_t WS_TT = WS_INVN + MiB;
constexpr size_t WS_CS = WS_TT + al((size_t)2 * 9216 * 1024 * 4);
constexpr size_t WS_FL256 = WS_CS + MiB;
constexpr size_t WS_FL2048 = WS_FL256 + MiB;
constexpr size_t WS_H8 = WS_FL2048 + al((size_t)2048 * 4096 * 2);
constexpr size_t WS_WIN8 = WS_H8 + al((size_t)MTOK * DM);
constexpr int N8 = 2048 + 2048 + 4096 + 12288;
constexpr size_t WS_END = WS_WIN8 + al((size_t)2 * N8 * DM);

#define GAS __attribute__((address_space(1)))
#define LAS __attribute__((address_space(3)))
typedef unsigned short bf16_t;
typedef short bf16x8 __attribute__((ext_vector_type(8)));
typedef float f32x4 __attribute__((ext_vector_type(4)));
typedef float f32x2 __attribute__((ext_vector_type(2)));
typedef float f32x16 __attribute__((ext_vector_type(16)));
typedef unsigned u32x4 __attribute__((ext_vector_type(4)));
typedef unsigned u32x2 __attribute__((ext_vector_type(2)));
typedef short s16x4 __attribute__((ext_vector_type(4)));
#define LDS_WAIT() asm volatile("s_waitcnt lgkmcnt(0)" ::: "memory")
#define VM_WAIT() asm volatile("s_waitcnt vmcnt(0)" ::: "memory")
__device__ __forceinline__ unsigned cvt_pk_bf16(float lo, float hi) { unsigned r; asm volatile("v_cvt_pk_bf16_f32 %0, %1, %2" : "=v"(r) : "v"(lo), "v"(hi)); return r; }
__device__ __forceinline__ bf16_t f2bf(float f) { return (bf16_t)(cvt_pk_bf16(f, 0.f) & 0xffffu); }
__device__ __forceinline__ float bf2f(unsigned h) { return __uint_as_float(h << 16); }
__device__ __forceinline__ unsigned pk_fp8x4(float a, float b, float c, float d) {
    a = __builtin_amdgcn_fmed3f(a, -448.f, 448.f); b = __builtin_amdgcn_fmed3f(b, -448.f, 448.f); c = __builtin_amdgcn_fmed3f(c, -448.f, 448.f); d = __builtin_amdgcn_fmed3f(d, -448.f, 448.f);
    int w = 0; w = __builtin_amdgcn_cvt_pk_fp8_f32(a, b, w, false); w = __builtin_amdgcn_cvt_pk_fp8_f32(c, d, w, true); return (unsigned)w; }
__device__ __forceinline__ float sigmoid_f(float x) { return __builtin_amdgcn_rcpf(1.f + __builtin_amdgcn_exp2f(-1.4426950408889634f * x)); }
__device__ __forceinline__ float silu_f(float x) { return x * sigmoid_f(x); }
__device__ __forceinline__ int lane_id() { int l; asm volatile("v_mbcnt_lo_u32_b32 %0, -1, 0\n\tv_mbcnt_hi_u32_b32 %0, -1, %0" : "=v"(l)); return l; }
__device__ __forceinline__ float sum_fq4(float s) {
    { auto r = __builtin_amdgcn_permlane16_swap(__float_as_uint(s), __float_as_uint(s), false, false); s = __uint_as_float(r[0]) + __uint_as_float(r[1]); }
    { auto r = __builtin_amdgcn_permlane32_swap(__float_as_uint(s), __float_as_uint(s), false, false); s = __uint_as_float(r[0]) + __uint_as_float(r[1]); }
    return s;
}
__device__ __forceinline__ float wave_sum(float v) {
    v += __int_as_float(__builtin_amdgcn_mov_dpp(__float_as_int(v), 0xB1, 0xF, 0xF, true));
    v += __int_as_float(__builtin_amdgcn_mov_dpp(__float_as_int(v), 0x4E, 0xF, 0xF, true));
    v += __int_as_float(__builtin_amdgcn_mov_dpp(__float_as_int(v), 0x141, 0xF, 0xF, true));
    v += __int_as_float(__builtin_amdgcn_mov_dpp(__float_as_int(v), 0x140, 0xF, 0xF, true));
    return sum_fq4(v);
}

namespace pg8 {
constexpr int BM = 256, BK = 64, HALF = 128, HTB = HALF * BK * 2, STAGE_BYTES = 8 * HTB, NXCD = 8, WGM = 8;
__host__ __device__ __forceinline__ int lds_byte(int r, int c) { const int st = (r >> 4) * 2 + (c >> 5), rr = r & 15, cc = c & 31, ob = rr * 64 + cc * 2; return st * 1024 + (ob ^ (((ob >> 9) & 1) << 5)); }
__host__ __device__ __forceinline__ void stage_rc(int b, int& R, int& C) { const int st = b / 1024, sb = b % 1024, swz = sb ^ (((sb >> 9) & 1) << 5); R = (st >> 1) * 16 + swz / 64; C = (st & 1) * 32 + (swz % 64) / 2; }
__host__ __device__ __forceinline__ int perm32(int rho) { const int n = rho >> 4, i = rho & 15; return 8 * (i >> 2) + 4 * n + (i & 3); }

struct Unit { const char* a; const char* b; int K, pm, pn, aux, f8; };
struct Gemm { int lda, ldb; };

__device__ __forceinline__ void tile_of(int L, int nM, int nN, int& pm, int& pn) {
    const int nwg = nM * nN; int wgid = L;
    { const int q = nwg / NXCD, r = nwg % NXCD, xcd = wgid % NXCD, off = wgid / NXCD; wgid = (xcd < r ? xcd * (q + 1) : r * (q + 1) + (xcd - r) * q) + off; }
    const int nig = WGM * nN, gid = wgid / nig, fm = gid * WGM, gsz = (nM - fm) < WGM ? (nM - fm) : WGM;
    pm = fm + ((wgid % nig) % gsz); pn = (wgid % nig) / gsz;
}

__device__ __forceinline__ void tile_of_id(int id, int nM, int nN, int& pm, int& pn) {
    const int nig = WGM * nN, gid = id / nig, fm = gid * WGM, gsz = (nM - fm) < WGM ? (nM - fm) : WGM;
    pm = fm + ((id % nig) % gsz); pn = (id % nig) / gsz;
}
template <int PERMK = 0, int F8 = 0, class Epi, class Sched>
__device__ __forceinline__ void gemm_phase(LAS unsigned char* lds, const Gemm g, const Sched& S, const Epi& E, int wave_) {
    constexpr bool ALIGN_EPI = true;
    int lane = lane_id(); asm volatile("" : "+v"(lane));
    const int wid = wave_, tid = wave_ * 64 + lane, wr = wid >> 2, wc = wid & 3, fr = lane & 15, fq = lane >> 4;
    unsigned voffA[2], voffB[2];
#pragma unroll
    for (int i = 0; i < 2; ++i) { int R, C; stage_rc(tid * 16 + i * 8192, R, C); const int Rb = PERMK == 1 ? (64 * ((R >> 4) & 1) + 16 * ((R >> 5) & 3) + (R & 15)) : PERMK == 3 ? (64 * (R >> 5) + 16 * ((R >> 2) & 3) + 4 * ((R >> 4) & 1) + (R & 3)) : ((R & ~31) + perm32(R & 31));
        voffA[i] = (unsigned)(R * g.lda + C) * 2u; voffB[i] = (unsigned)(Rb * g.ldb + C) * 2u; }
    const size_t kstep = (size_t)(BK * 2);
    const size_t hstepA = (size_t)HALF * g.lda * 2, hstepB = (size_t)(PERMK == 3 ? 8 : HALF) * g.ldb * 2;
    const unsigned ldsw = (unsigned)wid * 1024u;
    const int aoff = lds_byte(wr * 64 + fr, fq * 8), boff = lds_byte(wc * 32 + fr, fq * 8);
#define PG8_SA(b, h) (((b) * 2 + (h)) * HTB)
#define PG8_SB(b, h) ((4 + (b) * 2 + (h)) * HTB)
#define PG8_STAGE(bufoff, gbase, voff) do { _Pragma("unroll") for (int _i = 0; _i < 2; ++_i) { \
        if constexpr (F8 != 0) { unsigned keep_; const unsigned ldst_ = (unsigned)__builtin_amdgcn_readfirstlane((int)((unsigned)(uintptr_t)(lds + (bufoff) + ldsw + _i * 8192))); \
            asm volatile("s_mov_b32 %0, m0\n\ts_mov_b32 m0, %3\n\ts_nop 0\n\tglobal_load_lds_dwordx4 %1, %2\n\ts_mov_b32 m0, %0" : "=&s"(keep_) : "v"((voff)[_i]), "s"((const char*)(gbase)), "s"(ldst_) : "memory"); } \
        else __builtin_amdgcn_global_load_lds((const unsigned*)((const char*)(gbase) + (voff)[_i]), (LAS unsigned*)(lds + (bufoff) + ldsw + _i * 8192), 16, 0, 0); } } while (0)
    typedef int v4i_ __attribute__((ext_vector_type(4))); typedef int v8i_ __attribute__((ext_vector_type(8)));
#define PG8_LDA(dst, b, h) do { _Pragma("unroll") for (int m = 0; m < 4; ++m) { if constexpr (F8 != 0) { dst##8[m].lo = *(const LAS v4i_*)(lds + PG8_SA(b, h) + aoff + m * 2048); dst##8[m].hi = *(const LAS v4i_*)(lds + PG8_SA(b, h) + aoff + m * 2048 + 1024); } \
        else { _Pragma("unroll") for (int k = 0; k < 2; ++k) dst[m][k] = *(const LAS bf16x8*)(lds + PG8_SA(b, h) + aoff + m * 2048 + k * 1024); } } } while (0)
#define PG8_LDB(dst, b, h) do { _Pragma("unroll") for (int n = 0; n < 2; ++n) { if constexpr (F8 != 0) { dst##8[n].lo = *(const LAS v4i_*)(lds + PG8_SB(b, h) + boff + n * 2048); dst##8[n].hi = *(const LAS v4i_*)(lds + PG8_SB(b, h) + boff + n * 2048 + 1024); } \
        else { _Pragma("unroll") for (int k = 0; k < 2; ++k) dst[n][k] = *(const LAS bf16x8*)(lds + PG8_SB(b, h) + boff + n * 2048 + k * 1024); } } } while (0)
#define PG8_MMA8(ai, bj, At, Bt) do { __builtin_amdgcn_s_setprio(1); _Pragma("unroll") for (int m = 0; m < 4; ++m) _Pragma("unroll") for (int n = 0; n < 2; ++n) { \
        asm volatile("v_mfma_scale_f32_16x16x128_f8f6f4 %0, %1, %2, %0, %3, %4 op_sel_hi:[0,0,0]" : "+v"(acc[ai][bj][m][n]) : "v"(Bt##8[n]), "v"(At##8[m]), "v"(sclB_), "v"(sclA_)); } \
        __builtin_amdgcn_s_setprio(0); } while (0)
#define PG8_MMA16(ai, bj, At, Bt) do { __builtin_amdgcn_s_setprio(1); \
        if constexpr (F8 != 0) { \
            _Pragma("unroll") for (int m = 0; m < 4; ++m) _Pragma("unroll") for (int n = 0; n < 2; ++n) asm volatile("v_mfma_f32_16x16x32_bf16 %0, %1, %2, %0" : "+v"(acc[ai][bj][m][n]) : "v"(Bt##8[n].lo), "v"(At##8[m].lo)); \
            _Pragma("unroll") for (int m = 0; m < 4; ++m) _Pragma("unroll") for (int n = 0; n < 2; ++n) asm volatile("v_mfma_f32_16x16x32_bf16 %0, %1, %2, %0" : "+v"(acc[ai][bj][m][n]) : "v"(Bt##8[n].hi), "v"(At##8[m].hi)); } \
        else { _Pragma("unroll") for (int m = 0; m < 4; ++m) _Pragma("unroll") for (int n = 0; n < 2; ++n) { _Pragma("unroll") for (int k = 0; k < 2; ++k) acc[ai][bj][m][n] = __builtin_amdgcn_mfma_f32_16x16x32_bf16(Bt[n][k], At[m][k], acc[ai][bj][m][n], 0, 0, 0); } } \
        __builtin_amdgcn_s_setprio(0); } while (0)
#define PG8_WAIT_V(n) asm volatile("s_waitcnt vmcnt(" #n ")" ::: "memory")
#define PG8_WAIT_L(n) asm volatile("s_waitcnt lgkmcnt(" #n ")" ::: "memory")
#define PG8_BAR __builtin_amdgcn_s_barrier()
#define PG8_SCHED __builtin_amdgcn_sched_barrier(0)
    Unit cur, nxt; int ui = 0;
    const bool leader_ = (wid == 0) && (lane == 0);
    if constexpr (Sched::DYN) { if (leader_) { unsigned qc = S.x0; const unsigned o0 = S.draw(qc); const unsigned i0 = S.resolve(o0, qc, qc); const unsigned o1 = S.draw(qc); const unsigned i1 = S.resolve(o1, qc, qc); S.qs[0] = i0; S.qs[1] = i1; S.qs[2] = qc; }
        asm volatile("s_waitcnt vmcnt(0) lgkmcnt(0)" ::: "memory"); __builtin_amdgcn_s_barrier(); asm volatile("" ::: "memory"); }
    if (!S.next(0, cur)) return;
    f32x4 acc[2][2][4][2];
#pragma unroll
    for (int a = 0; a < 2; ++a)
#pragma unroll
        for (int b = 0; b < 2; ++b)
#pragma unroll
            for (int m = 0; m < 4; ++m)
#pragma unroll
                for (int n = 0; n < 2; ++n) acc[a][b][m][n] = (f32x4){0.f, 0.f, 0.f, 0.f};
    bf16x8 At[4][2], B0[2][2], B1[2][2]; v8i_ At8[4], B08[2], B18[2];
    int sclB_ = 0x79797979, sclA_ = (F8 == 2) ? 0x79797979 : 0x7f7f7f7f; if constexpr (F8 != 0) asm volatile("" : "+v"(sclB_), "+v"(sclA_));
    const char* cA = cur.a; const char* cB = cur.b;
    PG8_STAGE(PG8_SB(0, 0), cB, voffB); PG8_STAGE(PG8_SB(0, 1), cB + hstepB, voffB); PG8_STAGE(PG8_SA(0, 0), cA, voffA); PG8_STAGE(PG8_SA(0, 1), cA + hstepA, voffA);
    if (wr == 1) PG8_BAR;
    PG8_WAIT_V(2); PG8_BAR;
    PG8_STAGE(PG8_SB(1, 0), cB + kstep, voffB); PG8_STAGE(PG8_SA(1, 0), cA + kstep, voffA); PG8_STAGE(PG8_SB(1, 1), cB + hstepB + kstep, voffB);
    PG8_WAIT_V(6); PG8_BAR;
    for (;;) {
        const bool has_next = S.next(ui + 1, nxt);
        const char* nA = has_next ? nxt.a : cA; const char* nB = has_next ? nxt.b : cB;
        const int nt = cur.K / BK;
#define PG8_KLOOP(MMA) _Pragma("nounroll") for (int t = 0; t < nt; t += 2) { \
            unsigned pend_ = 0u; \
            if constexpr (Sched::DYN) { if (t == 2 && leader_) { unsigned* ap_ = S.ctr0 + S.qs[2] * 64; unsigned one_ = 1u; \
                    asm volatile("global_atomic_add %0, %1, %2, off sc0" : "=v"(pend_) : "v"(ap_), "v"(one_) : "memory"); } } \
            const bool last = (t == nt - 2); \
            const char* a1 = cA + (size_t)(t + 1) * kstep; \
            const char* a2 = last ? nA : cA + (size_t)(t + 2) * kstep; const char* b2 = last ? nB : cB + (size_t)(t + 2) * kstep; \
            const char* a3 = a2 + kstep; const char* b3 = b2 + kstep; \
            PG8_LDB(B0, 0, 0); PG8_LDB(B1, 0, 1); PG8_SCHED; PG8_LDA(At, 0, 0); PG8_STAGE(PG8_SA(1, 1), a1 + hstepA, voffA); \
            PG8_WAIT_V(8); PG8_WAIT_L(0); PG8_BAR; MMA(0, 0, At, B0); MMA(0, 1, At, B1); PG8_BAR; PG8_SCHED; \
            PG8_LDA(At, 0, 1); PG8_STAGE(PG8_SB(0, 0), b2, voffB); PG8_STAGE(PG8_SB(0, 1), b2 + hstepB, voffB); PG8_STAGE(PG8_SA(0, 0), a2, voffA); \
            PG8_WAIT_V(8); PG8_WAIT_L(0); PG8_BAR; MMA(1, 0, At, B0); MMA(1, 1, At, B1); PG8_BAR; PG8_SCHED; \
            PG8_LDB(B0, 1, 0); PG8_LDB(B1, 1, 1); PG8_SCHED; PG8_LDA(At, 1, 0); PG8_STAGE(PG8_SA(0, 1), a2 + hstepA, voffA); \
            PG8_WAIT_V(8); PG8_WAIT_L(0); PG8_BAR; MMA(0, 0, At, B0); MMA(0, 1, At, B1); PG8_BAR; PG8_SCHED; \
            PG8_LDA(At, 1, 1); PG8_STAGE(PG8_SB(1, 0), b3, voffB); PG8_STAGE(PG8_SB(1, 1), b3 + hstepB, voffB); PG8_STAGE(PG8_SA(1, 0), a3, voffA); \
            PG8_WAIT_V(8); PG8_WAIT_L(0); PG8_BAR; MMA(1, 0, At, B0); MMA(1, 1, At, B1); PG8_BAR; PG8_SCHED; \
            if constexpr (Sched::DYN) { if (t == 2 && leader_) { asm volatile("s_waitcnt vmcnt(8)" : "+v"(pend_) :: "memory"); \
                    unsigned qc = S.qs[2]; const unsigned id_ = S.resolve(pend_, qc, qc); S.qs[ui & 1] = id_; S.qs[2] = qc; } } \
        }
#define PG8_MMAX(ai, bj, At, Bt) do { __builtin_amdgcn_s_setprio(1); asm volatile( \
            "s_cmp_eq_u32 %[f], 0\n\ts_cbranch_scc1 1f\n\t" \
            "v_mfma_scale_f32_16x16x128_f8f6f4 %0, %[b0], %[a0], %0, %[sb], %[sa] op_sel_hi:[0,0,0]\n\t" \
            "v_mfma_scale_f32_16x16x128_f8f6f4 %1, %[b1], %[a0], %1, %[sb], %[sa] op_sel_hi:[0,0,0]\n\t" \
            "v_mfma_scale_f32_16x16x128_f8f6f4 %2, %[b0], %[a1], %2, %[sb], %[sa] op_sel_hi:[0,0,0]\n\t" \
            "v_mfma_scale_f32_16x16x128_f8f6f4 %3, %[b1], %[a1], %3, %[sb], %[sa] op_sel_hi:[0,0,0]\n\t" \
            "v_mfma_scale_f32_16x16x128_f8f6f4 %4, %[b0], %[a2], %4, %[sb], %[sa] op_sel_hi:[0,0,0]\n\t" \
            "v_mfma_scale_f32_16x16x128_f8f6f4 %5, %[b1], %[a2], %5, %[sb], %[sa] op_sel_hi:[0,0,0]\n\t" \
            "v_mfma_scale_f32_16x16x128_f8f6f4 %6, %[b0], %[a3], %6, %[sb], %[sa] op_sel_hi:[0,0,0]\n\t" \
            "v_mfma_scale_f32_16x16x128_f8f6f4 %7, %[b1], %[a3], %7, %[sb], %[sa] op_sel_hi:[0,0,0]\n\t" \
            "s_branch 2f\n1:\n\t" \
            "v_mfma_f32_16x16x32_bf16 %0, %[b0l], %[a0l], %0\n\t" \
            "v_mfma_f32_16x16x32_bf16 %1, %[b1l], %[a0l], %1\n\t" \
            "v_mfma_f32_16x16x32_bf16 %2, %[b0l], %[a1l], %2\n\t" \
            "v_mfma_f32_16x16x32_bf16 %3, %[b1l], %[a1l], %3\n\t" \
            "v_mfma_f32_16x16x32_bf16 %4, %[b0l], %[a2l], %4\n\t" \
            "v_mfma_f32_16x16x32_bf16 %5, %[b1l], %[a2l], %5\n\t" \
            "v_mfma_f32_16x16x32_bf16 %6, %[b0l], %[a3l], %6\n\t" \
            "v_mfma_f32_16x16x32_bf16 %7, %[b1l], %[a3l], %7\n\t" \
            "v_mfma_f32_16x16x32_bf16 %0, %[b0h], %[a0h], %0\n\t" \
            "v_mfma_f32_16x16x32_bf16 %1, %[b1h], %[a0h], %1\n\t" \
            "v_mfma_f32_16x16x32_bf16 %2, %[b0h], %[a1h], %2\n\t" \
            "v_mfma_f32_16x16x32_bf16 %3, %[b1h], %[a1h], %3\n\t" \
            "v_mfma_f32_16x16x32_bf16 %4, %[b0h], %[a2h], %4\n\t" \
            "v_mfma_f32_16x16x32_bf16 %5, %[b1h], %[a2h], %5\n\t" \
            "v_mfma_f32_16x16x32_bf16 %6, %[b0h], %[a3h], %6\n\t" \
            "v_mfma_f32_16x16x32_bf16 %7, %[b1h], %[a3h], %7\n\t" \
            "2:" \
            : "+v"(acc[ai][bj][0][0]), "+v"(acc[ai][bj][0][1]), "+v"(acc[ai][bj][1][0]), "+v"(acc[ai][bj][1][1]), "+v"(acc[ai][bj][2][0]), "+v"(acc[ai][bj][2][1]), "+v"(acc[ai][bj][3][0]), "+v"(acc[ai][bj][3][1]) \
            : [a0] "v"(At##8[0]), [a1] "v"(At##8[1]), [a2] "v"(At##8[2]), [a3] "v"(At##8[3]), [b0] "v"(Bt##8[0]), [b1] "v"(Bt##8[1]), [a0l] "v"(At##8[0].lo), [a0h] "v"(At##8[0].hi), [a1l] "v"(At##8[1].lo), [a1h] "v"(At##8[1].hi), [a2l] "v"(At##8[2].lo), [a2h] "v"(At##8[2].hi), [a3l] "v"(At##8[3].lo), [a3h] "v"(At##8[3].hi), [b0l] "v"(Bt##8[0].lo), [b0h] "v"(Bt##8[0].hi), [b1l] "v"(Bt##8[1].lo), [b1h] "v"(Bt##8[1].hi), [sb] "v"(sclB_), [sa] "v"(sclA_), [f] "s"(f8u_) \
            : "scc"); __builtin_amdgcn_s_setprio(0); } while (0)
        if constexpr (F8 == 2) { const int f8u_ = __builtin_amdgcn_readfirstlane(cur.f8); PG8_KLOOP(PG8_MMAX) }
        else if constexpr (F8 == 1) { PG8_KLOOP(PG8_MMA8) }
        else { PG8_KLOOP(PG8_MMA16) }
        if constexpr (ALIGN_EPI) { if (wr == 0) PG8_BAR; }
        if constexpr (F8 != 0) asm volatile("s_nop 15\n\ts_nop 15\n\ts_nop 7" ::: "memory");
        int fr_ = fr, fq_ = fq; asm volatile("" : "+v"(fr_), "+v"(fq_));
        Unit cu_ = cur; asm volatile("" : "+s"(cu_.pm), "+s"(cu_.pn), "+s"(cu_.aux));
        const bool keep = E(acc, cu_, wr, wc, fr_, fq_);
        if (!has_next) break;
        if (!keep) {
#pragma unroll
        for (int a = 0; a < 2; ++a)
#pragma unroll
            for (int b = 0; b < 2; ++b)
#pragma unroll
                for (int m = 0; m < 4; ++m)
#pragma unroll
                    for (int n = 0; n < 2; ++n) acc[a][b][m][n] = (f32x4){0.f, 0.f, 0.f, 0.f};
        }
        cur = nxt; cA = nA; cB = nB; ++ui;
        if constexpr (ALIGN_EPI) { if (wr == 1) PG8_BAR; }
    }
    PG8_WAIT_V(0);
    if constexpr (!ALIGN_EPI) { if (wr == 0) PG8_BAR; }
    PG8_BAR;
#undef PG8_SA
#undef PG8_SB
#undef PG8_STAGE
#undef PG8_LDA
#undef PG8_LDB
#undef PG8_MMA8
#undef PG8_MMA16
#undef PG8_KLOOP
#undef PG8_MMAX
#undef PG8_WAIT_V
#undef PG8_WAIT_L
#undef PG8_BAR
#undef PG8_SCHED
}

#define EPI_PIN(p) asm volatile("" : "+v"(p) :: "memory")
#define EPI_ADDR4(pa, ptr, stride_bytes, hf) do { const GAS char* lp_ = (ptr) + (size_t)(hf) * 128 * (stride_bytes); _Pragma("unroll") for (int m = 0; m < 4; ++m) { pa[m] = lp_; lp_ += (size_t)16 * (stride_bytes); asm volatile("" : "+v"(lp_)); } } while (0)
#define EPI_ALOAD8_NOWAIT(arr, pa) asm volatile("global_load_dwordx4 %0, %8, off\n\tglobal_load_dwordx4 %1, %8, off offset:256\n\tglobal_load_dwordx4 %2, %9, off\n\tglobal_load_dwordx4 %3, %9, off offset:256\n\t" \
        "global_load_dwordx4 %4, %10, off\n\tglobal_load_dwordx4 %5, %10, off offset:256\n\tglobal_load_dwordx4 %6, %11, off\n\tglobal_load_dwordx4 %7, %11, off offset:256" \
        : "=&v"(arr[0][0]), "=&v"(arr[0][1]), "=&v"(arr[1][0]), "=&v"(arr[1][1]), "=&v"(arr[2][0]), "=&v"(arr[2][1]), "=&v"(arr[3][0]), "=&v"(arr[3][1]) : "v"(pa[0]), "v"(pa[1]), "v"(pa[2]), "v"(pa[3]) : "memory")
#define EPI_ALOAD8_WAIT(arr, pa, keep) asm volatile("global_load_dwordx4 %0, %16, off\n\tglobal_load_dwordx4 %1, %16, off offset:256\n\tglobal_load_dwordx4 %2, %17, off\n\tglobal_load_dwordx4 %3, %17, off offset:256\n\t" \
        "global_load_dwordx4 %4, %18, off\n\tglobal_load_dwordx4 %5, %18, off offset:256\n\tglobal_load_dwordx4 %6, %19, off\n\tglobal_load_dwordx4 %7, %19, off offset:256\n\ts_waitcnt vmcnt(0)" \
        : "=&v"(arr[0][0]), "=&v"(arr[0][1]), "=&v"(arr[1][0]), "=&v"(arr[1][1]), "=&v"(arr[2][0]), "=&v"(arr[2][1]), "=&v"(arr[3][0]), "=&v"(arr[3][1]), \
          "+v"(keep[0][0]), "+v"(keep[0][1]), "+v"(keep[1][0]), "+v"(keep[1][1]), "+v"(keep[2][0]), "+v"(keep[2][1]), "+v"(keep[3][0]), "+v"(keep[3][1]) : "v"(pa[0]), "v"(pa[1]), "v"(pa[2]), "v"(pa[3]) : "memory")
#define EPI_ALOAD8H_NOWAIT(arr, pa) asm volatile("global_load_dwordx2 %0, %8, off\n\tglobal_load_dwordx2 %1, %8, off offset:128\n\tglobal_load_dwordx2 %2, %9, off\n\tglobal_load_dwordx2 %3, %9, off offset:128\n\t" \
        "global_load_dwordx2 %4, %10, off\n\tglobal_load_dwordx2 %5, %10, off offset:128\n\tglobal_load_dwordx2 %6, %11, off\n\tglobal_load_dwordx2 %7, %11, off offset:128" \
        : "=&v"(arr[0][0]), "=&v"(arr[0][1]), "=&v"(arr[1][0]), "=&v"(arr[1][1]), "=&v"(arr[2][0]), "=&v"(arr[2][1]), "=&v"(arr[3][0]), "=&v"(arr[3][1]) : "v"(pa[0]), "v"(pa[1]), "v"(pa[2]), "v"(pa[3]) : "memory")
#define EPI_ALOAD8H_WAIT(arr, pa, keep) asm volatile("global_load_dwordx2 %0, %16, off\n\tglobal_load_dwordx2 %1, %16, off offset:128\n\tglobal_load_dwordx2 %2, %17, off\n\tglobal_load_dwordx2 %3, %17, off offset:128\n\t" \
        "global_load_dwordx2 %4, %18, off\n\tglobal_load_dwordx2 %5, %18, off offset:128\n\tglobal_load_dwordx2 %6, %19, off\n\tglobal_load_dwordx2 %7, %19, off offset:128\n\ts_waitcnt vmcnt(0)" \
        : "=&v"(arr[0][0]), "=&v"(arr[0][1]), "=&v"(arr[1][0]), "=&v"(arr[1][1]), "=&v"(arr[2][0]), "=&v"(arr[2][1]), "=&v"(arr[3][0]), "=&v"(arr[3][1]), \
          "+v"(keep[0][0]), "+v"(keep[0][1]), "+v"(keep[1][0]), "+v"(keep[1][1]), "+v"(keep[2][0]), "+v"(keep[2][1]), "+v"(keep[3][0]), "+v"(keep[3][1]) : "v"(pa[0]), "v"(pa[1]), "v"(pa[2]), "v"(pa[3]) : "memory")
#define EPI_LOAD16(arr, ptr, stride_bytes, AI0, AI1) do { const GAS char* lp_ = (ptr); \
    _Pragma("unroll") for (int ai = 0; ai < 2; ++ai) _Pragma("unroll") for (int m = 0; m < 4; ++m) { \
        if (ai >= (AI0) && ai < (AI1)) { _Pragma("unroll") for (int bj = 0; bj < 2; ++bj) arr[(ai - (AI0)) * 4 + m][bj] = *(const GAS u32x4*)(lp_ + bj * 256); } \
        lp_ += (size_t)((m == 3) ? 80 : 16) * (stride_bytes); asm volatile("" : "+v"(lp_)); } } while (0)
#define EPI_ROWS(...) \
    _Pragma("unroll") for (int ai = 0; ai < 2; ++ai) _Pragma("unroll") for (int m = 0; m < 4; ++m) { \
    _Pragma("unroll") for (int bj = 0; bj < 2; ++bj) { f32x4 v0 = acc[ai][bj][m][0], v1 = acc[ai][bj][m][1]; __VA_ARGS__ } \
    const int adv = (m == 3) ? 80 : 16;
#define EPI_END }
#define EPI_ROWS2(...) \
    _Pragma("unroll") for (int ai = 0; ai < 2; ++ai) _Pragma("unroll") for (int m = 0; m < 4; ++m) { \
    { f32x4 a0 = acc[ai][0][m][0], a1 = acc[ai][0][m][1], b0 = acc[ai][1][m][0], b1 = acc[ai][1][m][1]; __VA_ARGS__ } \
    const int adv = (m == 3) ? 80 : 16;

__device__ __forceinline__ u32x4 pack8(f32x4 v0, f32x4 v1) { u32x4 w; w.x = cvt_pk_bf16(v0[0], v0[1]); w.y = cvt_pk_bf16(v0[2], v0[3]); w.z = cvt_pk_bf16(v1[0], v1[1]); w.w = cvt_pk_bf16(v1[2], v1[3]); return w; }
__device__ __forceinline__ void unpack8f8(u32x2 w, f32x4& a, f32x4& b) {
    const auto a0 = __builtin_amdgcn_cvt_pk_f32_fp8((int)w.x, false), a1 = __builtin_amdgcn_cvt_pk_f32_fp8((int)w.x, true), b0 = __builtin_amdgcn_cvt_pk_f32_fp8((int)w.y, false), b1 = __builtin_amdgcn_cvt_pk_f32_fp8((int)w.y, true);
    a = (f32x4){a0[0], a0[1], a1[0], a1[1]}; b = (f32x4){b0[0], b0[1], b1[0], b1[1]}; }
__device__ __forceinline__ void unpack8(u32x4 w, f32x4& a, f32x4& b) { a = (f32x4){bf2f(w.x & 0xffffu), bf2f(w.x >> 16), bf2f(w.y & 0xffffu), bf2f(w.y >> 16)}; b = (f32x4){bf2f(w.z & 0xffffu), bf2f(w.z >> 16), bf2f(w.w & 0xffffu), bf2f(w.w >> 16)}; }

struct EpiProj {
    bf16_t* proj; bf16_t* Qp; bf16_t* KCp; bf16_t* VCp; bf16_t* KLp; bf16_t* VLp; bf16_t* URC; bf16_t* URL; float* outk; float* outv;
    LAS float* xch; int l;
    __device__ __forceinline__ bool operator()(f32x4 (&acc)[2][2][4][2], const Unit& u, int wr, int wc, int fr, int fq) const {
        const int pn = u.pn, pm = u.pm; const int cl = 16 * wc + 4 * fq;
        if (pn >= 28 && pn < 40) {
            const int chl = (pn - 28) * 256 + wr * 64 + fr; const bool ctx = pm < 32; const int q = pm - 32;
            const int L = ctx ? L_CTX : L_LAT, nseq = ctx ? 32 : 2, sq = ctx ? pm : (q >> 3), pos0 = ctx ? 0 : (q & 7) * 256;
            bf16_t* base = ctx ? URC : URL;
            const int comp = ((pn - 28) * 256) >> 10; const int ch = chl & 1023;
            GAS char* p = (GAS char*)(base + (((size_t)comp * nseq + sq) * 1024 + ch) * L + pos0 + cl);
            EPI_ROWS({ u32x2 w0; w0.x = cvt_pk_bf16(v0[0], v0[1]); w0.y = cvt_pk_bf16(v0[2], v0[3]); u32x2 w1; w1.x = cvt_pk_bf16(v1[0], v1[1]); w1.y = cvt_pk_bf16(v1[2], v1[3]);
                       *(GAS u32x2*)(p + bj * 256) = w0; *(GAS u32x2*)(p + bj * 256 + 128) = w1; }) p += (size_t)adv * L * 2; EPI_PIN(p); EPI_END
            return false;
        }
        const size_t row = (size_t)pm * BM + wr * 64 + fr;
        if (pn >= 12) {
            const float msk = (pn >= 20 && pn < 24) ? 0.f : 1.f;
            GAS char* p = (GAS char*)(proj + row * INW + pn * BM + cl);
            EPI_ROWS({ _Pragma("unroll") for (int e = 0; e < 4; ++e) { v0[e] *= fmaf(sigmoid_f(v0[e]), msk, 1.f - msk); v1[e] *= fmaf(sigmoid_f(v1[e]), msk, 1.f - msk); }
                       u32x2 w0; w0.x = cvt_pk_bf16(v0[0], v0[1]); w0.y = cvt_pk_bf16(v0[2], v0[3]); u32x2 w1; w1.x = cvt_pk_bf16(v1[0], v1[1]); w1.y = cvt_pk_bf16(v1[2], v1[3]);
                       *(GAS u32x2*)(p + bj * 256) = w0; *(GAS u32x2*)(p + bj * 256 + 128) = w1; }) p += (size_t)adv * INW * 2; EPI_PIN(p); EPI_END
            return false;
        }
        const bool lat = pm >= 32; const int ql = pm - 32; const int sq = lat ? (ql >> 3) : pm; const int pos = (lat ? (ql & 7) * 256 : 0) + wr * 64 + fr;
        if (pn < 10) {
            const int rl = wr * 64 + fr;
            { LAS float* xp = xch + rl * 8 + wc;
              EPI_ROWS({ float s_ = (v0[0] * v0[0] + v0[1] * v0[1]) + (v0[2] * v0[2] + v0[3] * v0[3]) + (v1[0] * v1[0] + v1[1] * v1[1]) + (v1[2] * v1[2] + v1[3] * v1[3]);
                         s_ = sum_fq4(s_); if (fq == 0) xp[bj * 4] = s_; }) xp += adv * 8; EPI_END }
            asm volatile("s_waitcnt lgkmcnt(0)" ::: "memory"); __builtin_amdgcn_s_barrier(); asm volatile("" ::: "memory");
            const LAS float* gv = xch + 2048 + ((pn < 8) ? 0 : 128); const f32x4 g0 = *(const LAS f32x4*)(gv + cl), g1 = *(const LAS f32x4*)(gv + 64 + cl);
            f32x4 cst[4], snt[4];
            if (lat) { f32x4 inv; _Pragma("unroll") for (int e = 0; e < 4; ++e) inv[e] = __builtin_amdgcn_exp2f(-(float)((cl + e) & 31) * 0.41524101186092029f);
                _Pragma("unroll") for (int k = 0; k < 4; ++k) { const float bs = (wc < 2) ? (float)(4 * (ql & 7) + 2 * k + wr) : (float)(16 * k + fr);
                    _Pragma("unroll") for (int e = 0; e < 4; ++e) { const float rv = bs * inv[e] * 0.15915494309189535f; cst[k][e] = __builtin_amdgcn_cosf(rv); snt[k][e] = __builtin_amdgcn_sinf(rv); } } }
            const LAS float* xq = xch + rl * 8;
            if (pn < 8) {
                GAS char* p = (GAS char*)Qp + row * 2048 + pn * BM + cl;
                EPI_ROWS({ const f32x4 t4 = *(const LAS f32x4*)(xq + bj * 4); const float rs = 1.0f / sqrtf(((t4[0] + t4[1]) + (t4[2] + t4[3])) * (1.f / 128.f) + EPS);
                           f32x4 y0 = v0 * rs * g0, y1 = v1 * rs * g1;
                           if (lat) { const f32x4 cs = (wc < 2) ? cst[ai] : cst[m], sn = (wc < 2) ? snt[ai] : snt[m]; const f32x4 r0 = y0 * cs - y1 * sn, r1 = y1 * cs + y0 * sn; y0 = r0; y1 = r1; }
                           *(GAS unsigned*)(p + bj * 128) = pk_fp8x4(y0[0], y0[1], y0[2], y0[3]); *(GAS unsigned*)(p + bj * 128 + 64) = pk_fp8x4(y1[0], y1[1], y1[2], y1[3]); })
                    p += (size_t)adv * 2048; xq += adv * 8; EPI_PIN(p); EPI_END
            } else {
                const int hc = (pn - 8) * BM + cl;
                GAS char* p = (GAS char*)((lat ? KLp + ((size_t)sq * KV_LAT + pos) * 512 : KCp + row * 512) + hc);
                GAS char* po = (GAS char*)(outk + ((size_t)(sq * 2 + l) * 256 + (lat ? 0 : pos)) * 512 + hc);
                EPI_ROWS({ const f32x4 t4 = *(const LAS f32x4*)(xq + bj * 4); const float rs = 1.0f / sqrtf(((t4[0] + t4[1]) + (t4[2] + t4[3])) * (1.f / 128.f) + EPS);
                           f32x4 y0 = v0 * rs * g0, y1 = v1 * rs * g1;
                           if (!lat) { *(GAS f32x4*)(po + bj * 512) = y0; *(GAS f32x4*)(po + bj * 512 + 256) = y1; }
                           else { const f32x4 cs = (wc < 2) ? cst[ai] : cst[m], sn = (wc < 2) ? snt[ai] : snt[m]; const f32x4 r0 = y0 * cs - y1 * sn, r1 = y1 * cs + y0 * sn; y0 = r0; y1 = r1; }
                           u32x2 w0; w0.x = cvt_pk_bf16(y0[0], y0[1]); w0.y = cvt_pk_bf16(y0[2], y0[3]); u32x2 w1; w1.x = cvt_pk_bf16(y1[0], y1[1]); w1.y = cvt_pk_bf16(y1[2], y1[3]);
                           *(GAS u32x2*)(p + bj * 256) = w0; *(GAS u32x2*)(p + bj * 256 + 128) = w1; })
                    p += (size_t)adv * 512 * 2; po += (size_t)adv * 512 * 4; xq += adv * 8; EPI_PIN(p); EPI_PIN(po); EPI_END
            }
        } else {
            const int hc = (pn - 10) * BM + cl;
            GAS char* p = (GAS char*)((lat ? VLp + ((size_t)sq * KV_LAT + pos) * 512 : VCp + row * 512) + hc);
            GAS char* po = (GAS char*)(outv + ((size_t)(sq * 2 + l) * 256 + (lat ? 0 : pos)) * 512 + hc);
            EPI_ROWS({ if (!lat) { *(GAS f32x4*)(po + bj * 512) = v0; *(GAS f32x4*)(po + bj * 512 + 256) = v1; }
                       u32x2 w0; w0.x = cvt_pk_bf16(v0[0], v0[1]); w0.y = cvt_pk_bf16(v0[2], v0[3]); u32x2 w1; w1.x = cvt_pk_bf16(v1[0], v1[1]); w1.y = cvt_pk_bf16(v1[2], v1[3]);
                       *(GAS u32x2*)(p + bj * 256) = w0; *(GAS u32x2*)(p + bj * 256 + 128) = w1; })
                p += (size_t)adv * 512 * 2; po += (size_t)adv * 512 * 4; EPI_PIN(p); EPI_PIN(po); EPI_END
        }
        return false;
    }
};
struct EpiRest {
    bf16_t* proj; bf16_t* VCp; bf16_t* VLp; bf16_t* URC; bf16_t* URL; float* outv; int l;
    __device__ __forceinline__ bool in_place(const Unit& u) const { return (void)u, false; }
    __device__ __forceinline__ bool operator()(f32x4 (&acc)[2][2][4][2], const Unit& u, int wr, int wc, int fr, int fq) const {
        const int pn = u.pn, pm = u.pm; const int cw = 32 * wc + 8 * fq;
        if (pn >= 28 && pn < 40) {
            const int chl = (pn - 28) * 256 + wr * 64 + fr; const bool ctx = pm < 32; const int q = pm - 32;
            const int L = ctx ? L_CTX : L_LAT, nseq = ctx ? 32 : 2, sq = ctx ? pm : (q >> 3), pos0 = ctx ? 0 : (q & 7) * 256;
            bf16_t* base = ctx ? URC : URL; const int comp = ((pn - 28) * 256) >> 10; const int ch = chl & 1023;
            GAS char* p = (GAS char*)(base + (((size_t)comp * nseq + sq) * 1024 + ch) * L + pos0 + cw);
            EPI_ROWS({ *(GAS u32x4*)(p + bj * 256) = pack8(v0, v1); }) p += (size_t)adv * L * 2; EPI_PIN(p); EPI_END
            return false;
        }
        const size_t row = (size_t)pm * BM + wr * 64 + fr;
        if (pn >= 12) {
            const float msk = (pn >= 20 && pn < 24) ? 0.f : 1.f;
            GAS char* p = (GAS char*)(proj + row * INW + pn * BM + cw);
            EPI_ROWS({ _Pragma("unroll") for (int e = 0; e < 4; ++e) { v0[e] *= fmaf(sigmoid_f(v0[e]), msk, 1.f - msk); v1[e] *= fmaf(sigmoid_f(v1[e]), msk, 1.f - msk); }
                       *(GAS u32x4*)(p + bj * 256) = pack8(v0, v1); }) p += (size_t)adv * INW * 2; EPI_PIN(p); EPI_END
            return false;
        }
        const bool lat = pm >= 32; const int ql = pm - 32; const int sq = lat ? (ql >> 3) : pm; const int pos = (lat ? (ql & 7) * 256 : 0) + wr * 64 + fr;
        const int hc = (pn - 10) * BM + cw;
        GAS char* p = (GAS char*)((lat ? VLp + ((size_t)sq * KV_LAT + pos) * 512 : VCp + row * 512) + hc);
        GAS char* po = (GAS char*)(outv + ((size_t)(sq * 2 + l) * 256 + (lat ? 0 : pos)) * 512 + hc);
        EPI_ROWS({ if (!lat) { *(GAS f32x4*)(po + bj * 512) = v0; *(GAS f32x4*)(po + bj * 512 + 16) = v1; }
                   *(GAS u32x4*)(p + bj * 256) = pack8(v0, v1); })
            p += (size_t)adv * 512 * 2; po += (size_t)adv * 512 * 4; EPI_PIN(p); EPI_PIN(po); EPI_END
        return false;
    }
};
struct EpiSig {
    bf16_t* proj; bf16_t* URC; bf16_t* URL;
    __device__ __forceinline__ bool operator()(f32x4 (&acc)[2][2][4][2], const Unit& u, int wr, int wc, int fr, int fq) const {
        if (u.pn >= 28 && u.pn < 40) {
            const int pn = u.pn, pm = u.pm; const int cw = 64 * wc + 16 * fq;
            const int chl = (pn - 28) * 256 + wr * 64 + fr; const bool ctx = pm < 32; const int q = pm - 32;
            const int L = ctx ? L_CTX : L_LAT, nseq = ctx ? 32 : 2, sq = ctx ? pm : (q >> 3), pos0 = ctx ? 0 : (q & 7) * 256;
            bf16_t* base = ctx ? URC : URL; const int comp = ((pn - 28) * 256) >> 10; const int ch = chl & 1023;
            GAS char* p = (GAS char*)base + (((size_t)comp * nseq + sq) * 1024 + ch) * L + pos0 + cw;
            EPI_ROWS2({ u32x4 w; w.x = pk_fp8x4(a0[0], a0[1], a0[2], a0[3]); w.y = pk_fp8x4(a1[0], a1[1], a1[2], a1[3]); w.z = pk_fp8x4(b0[0], b0[1], b0[2], b0[3]); w.w = pk_fp8x4(b1[0], b1[1], b1[2], b1[3]); *(GAS u32x4*)p = w; }) p += (size_t)adv * L; EPI_PIN(p); EPI_END
            return false;
        }
        GAS char* p = (GAS char*)proj + ((size_t)u.pm * BM + wr * 64 + fr) * INW * 2 + (size_t)(u.pn < 28 ? C_AG : C_HG) + (size_t)u.pn * BM + 64 * wc + 16 * fq;
        EPI_ROWS2({ _Pragma("unroll") for (int e = 0; e < 4; ++e) { a0[e] *= sigmoid_f(a0[e]); a1[e] *= sigmoid_f(a1[e]); b0[e] *= sigmoid_f(b0[e]); b1[e] *= sigmoid_f(b1[e]); }
                    u32x4 w; w.x = pk_fp8x4(a0[0], a0[1], a0[2], a0[3]); w.y = pk_fp8x4(a1[0], a1[1], a1[2], a1[3]); w.z = pk_fp8x4(b0[0], b0[1], b0[2], b0[3]); w.w = pk_fp8x4(b1[0], b1[1], b1[2], b1[3]); *(GAS u32x4*)p = w; }) p += (size_t)adv * INW * 2; EPI_PIN(p); EPI_END
        return false;
    }
};
struct EpiT {
    bf16_t* proj;
    __device__ __forceinline__ bool operator()(f32x4 (&acc)[2][2][4][2], const Unit& u, int wr, int wc, int fr, int fq) const {
        GAS char* p = (GAS char*)(proj + ((size_t)u.pm * BM + wr * 64 + fr) * INW + u.pn * BM + 32 * wc + 8 * fq);
        EPI_ROWS({ _Pragma("unroll") for (int e = 0; e < 4; ++e) { v0[e] = fminf(1.f + __builtin_amdgcn_exp2f(v0[e]), 1048576.f); v1[e] = fminf(1.f + __builtin_amdgcn_exp2f(v1[e]), 1048576.f); }
                   *(GAS u32x4*)(p + bj * 256) = pack8(v0, v1); }) p += (size_t)adv * INW * 2; EPI_PIN(p); EPI_END
        return false;
    }
};
struct EpiT8 {
    bf16_t* proj;
    __device__ __forceinline__ bool operator()(f32x4 (&acc)[2][2][4][2], const Unit& u, int wr, int wc, int fr, int fq) const {
        const int g = (u.pn - 44) >> 4;
        GAS char* p = (GAS char*)proj + ((size_t)u.pm * BM + wr * 64 + fr) * INW * 2 + (size_t)(C_GA + g * DM) + (size_t)u.pn * BM + 64 * wc + 16 * fq;
        EPI_ROWS2({ _Pragma("unroll") for (int e = 0; e < 4; ++e) { a0[e] = 1.f + __builtin_amdgcn_exp2f(a0[e]); a1[e] = 1.f + __builtin_amdgcn_exp2f(a1[e]); b0[e] = 1.f + __builtin_amdgcn_exp2f(b0[e]); b1[e] = 1.f + __builtin_amdgcn_exp2f(b1[e]); }
                    u32x4 w; w.x = pk_fp8x4(a0[0], a0[1], a0[2], a0[3]); w.y = pk_fp8x4(a1[0], a1[1], a1[2], a1[3]); w.z = pk_fp8x4(b0[0], b0[1], b0[2], b0[3]); w.w = pk_fp8x4(b1[0], b1[1], b1[2], b1[3]); *(GAS u32x4*)p = w; }) p += (size_t)adv * INW * 2; EPI_PIN(p); EPI_END
        return false;
    }
};
struct EpiChan {
    bf16_t* UC; bf16_t* UL;
    __device__ __forceinline__ bool operator()(f32x4 (&acc)[2][2][4][2], const Unit& u, int wr, int wc, int fr, int fq) const {
        const int tt = u.pn, g = u.aux, pm = u.pm; const int rl = wr * 64 + fr, cl = wc * 32 + 8 * fq;
        const bool ctx = tt < 32; const int q = tt - 32, sq = ctx ? tt : (q >> 3), blk = q & 7; const int ldc = ctx ? 512 : 4096;
        bf16_t* base = ctx ? UC : UL; const int coff = ctx ? pm * 256 : pm * 2048 + blk * 256;
        GAS char* p = (GAS char*)(base + (((size_t)sq * 1024 + g * 256 + rl) * ldc + coff + cl));
        EPI_ROWS({ *(GAS u32x4*)(p + bj * 256) = pack8(v0, v1); }) p += (size_t)adv * ldc * 2; EPI_PIN(p); EPI_END
        return false;
    }
};
struct EpiGate {
    bf16_t* BRp; const bf16_t* PR;
    __device__ __forceinline__ bool operator()(f32x4 (&acc)[2][2][4][2], const Unit& u, int wr, int wc, int fr, int fq) const {
        const size_t row = (size_t)u.aux + wr * 64 + fr; const int col = u.pn * BM + wc * 32 + 8 * fq;
        GAS char* p = (GAS char*)(BRp + row * DM + 2048 + col); const GAS char* gp = (const GAS char*)(PR + row * INW + C_FG + col);
        u32x4 gq[8][2]; EPI_LOAD16(gq, gp, INW * 2, 0, 2);
        EPI_ROWS({ f32x4 g0, g1; unpack8(gq[ai * 4 + m][bj], g0, g1); *(GAS u32x4*)(p + bj * 256) = pack8(v0 * g0, v1 * g1); }) p += (size_t)adv * DM * 2; EPI_PIN(p); EPI_END
        return false;
    }
};
struct EpiMerge {
    bf16_t* MGp; const bf16_t* PR;
    __device__ __forceinline__ bool operator()(f32x4 (&acc)[2][2][4][2], const Unit& u, int wr, int wc, int fr, int fq) const {
        const size_t row = (size_t)u.pm * BM + wr * 64 + fr; const int col = u.pn * BM + wc * 32 + 8 * fq; const int seg = u.aux;
        const GAS char* rowb = (const GAS char*)PR + row * INW * 2;
        const GAS char* px_ = rowb + (size_t)(C_GA + (seg == 0 ? 0 : 2 * DM)) * 2 + col;
        if (seg < 2) {
            const GAS char* pf_ = rowb + (size_t)(C_GA + DM + col) * 2;
            const bool s0 = (seg == 0);
#pragma unroll
            for (int hf = 0; hf < 2; ++hf) {
                u32x2 x8[4][2]; u32x4 f16[4][2]; const GAS char* pa[4]; EPI_ADDR4(pa, px_, INW * 2, hf); EPI_ALOAD8H_NOWAIT(x8, pa); EPI_ADDR4(pa, pf_, INW * 2, hf); EPI_ALOAD8_WAIT(f16, pa, x8);
#pragma unroll
                for (int m = 0; m < 4; ++m)
#pragma unroll
                    for (int bj = 0; bj < 2; ++bj) { f32x4 x0, x1, f0, f1; unpack8f8(x8[m][bj], x0, x1); unpack8(f16[m][bj], f0, f1);
#pragma unroll
                        for (int e = 0; e < 4; ++e) { acc[hf][bj][m][0][e] *= (s0 ? f0[e] : x0[e]) * __builtin_amdgcn_rcpf(s0 ? x0[e] : f0[e]); acc[hf][bj][m][1][e] *= (s0 ? f1[e] : x1[e]) * __builtin_amdgcn_rcpf(s0 ? x1[e] : f1[e]); } }
            }
            return true;
        }
        GAS char* q = (GAS char*)(MGp + row * DM + col);
        u32x2 gq[2][4][2]; { const GAS char* pa[4]; EPI_ADDR4(pa, px_, INW * 2, 0); EPI_ALOAD8H_NOWAIT(gq[0], pa); EPI_ADDR4(pa, px_, INW * 2, 1); EPI_ALOAD8H_WAIT(gq[1], pa, gq[0]); }
        EPI_ROWS({ f32x4 g0, g1; unpack8f8(gq[ai][m][bj], g0, g1); _Pragma("unroll") for (int e = 0; e < 4; ++e) { v0[e] *= __builtin_amdgcn_rcpf(g0[e]); v1[e] *= __builtin_amdgcn_rcpf(g1[e]); } *(GAS u32x4*)(q + bj * 256) = pack8(v0, v1); }) q += (size_t)adv * DM * 2; EPI_PIN(q); EPI_END
        return false;
    }
};
struct EpiPart {
    float* Pp;
    __device__ __forceinline__ bool operator()(f32x4 (&acc)[2][2][4][2], const Unit& u, int wr, int wc, int fr, int fq) const {
        GAS char* p = (GAS char*)((bf16_t*)Pp + ((size_t)u.aux * M_LAT + (size_t)u.pm * BM + wr * 64 + fr) * 1024 + u.pn * BM + wc * 32 + 8 * fq);
        EPI_ROWS({ *(GAS u32x4*)(p + bj * 256) = pack8(v0, v1); }) p += (size_t)adv * 1024 * 2; EPI_PIN(p); EPI_END
        return false;
    }
};
struct EpiO16 {
    bf16_t* O;
    __device__ __forceinline__ bool operator()(f32x4 (&acc)[2][2][4][2], const Unit& u, int wr, int wc, int fr, int fq) const {
        GAS char* p = (GAS char*)(O + ((size_t)u.pm * BM + wr * 64 + fr) * DM + u.pn * BM + wc * 32 + 8 * fq);
        EPI_ROWS({ *(GAS u32x4*)(p + bj * 256) = pack8(v0, v1); }) p += (size_t)adv * DM * 2; EPI_PIN(p); EPI_END
        return false;
    }
};
}

namespace att {
constexpr int D = 128, NW = 8, QBLK = 32, KVBLK = 64;
constexpr float SCALE = 0.088388347648318440f;
constexpr float THR = 8.f;
constexpr int LDQ = 2048, LDK = 512, LDO = 4096, LDG = INW;
constexpr size_t SHM_V = KVBLK * D * 2, SHM_K = KVBLK * D * 2, SHM_ATTN = 2 * SHM_V + 2 * SHM_K + NW * 64 * 4;
#define KSWZ(row, colB) ((row) * 256 + ((colB) ^ (((row) & 7) << 4)))
#define SBAR() __builtin_amdgcn_sched_barrier(0)
__device__ __forceinline__ int crow(int r, int hi) { return (r & 3) + 8 * (r >> 2) + 4 * hi; }
__device__ __forceinline__ void partialSM(f32x16& p0, f32x16& p1, float& m_reg, float& mn, float& alpha) {
  constexpr float C = SCALE * 1.4426950408889634f;
  float pmax = p0[0]; for (int r = 1; r < 16; ++r) pmax = fmaxf(pmax, p0[r]); for (int r = 0; r < 16; ++r) pmax = fmaxf(pmax, p1[r]);
  { auto rr = __builtin_amdgcn_permlane32_swap(__float_as_uint(pmax), __float_as_uint(pmax), false, false);
    pmax = fmaxf(__uint_as_float(rr[0]), __uint_as_float(rr[1])); }
  if (__builtin_expect(__all(pmax - m_reg <= THR / SCALE), 1)) { mn = m_reg; alpha = 1.f; }
  else { mn = fmaxf(m_reg, pmax); alpha = __builtin_amdgcn_exp2f((m_reg - mn) * C); m_reg = mn; }
  float mnC = -mn * C;
  for (int r = 0; r < 16; ++r) p0[r] = fmaf(p0[r], C, mnC); for (int r = 0; r < 16; ++r) p1[r] = fmaf(p1[r], C, mnC);
  for (int r = 0; r < 16; ++r) p0[r] = __builtin_amdgcn_exp2f(p0[r]);
}
__device__ __forceinline__ void finishSM(f32x16& p0, f32x16& p1, float alpha, float& l_reg, bf16x8& pa0, bf16x8& pa1, bf16x8& pa2, bf16x8& pa3) {
  for (int r = 0; r < 16; ++r) p1[r] = __builtin_amdgcn_exp2f(p1[r]);
  float ps = 0; for (int r = 0; r < 16; ++r) ps += p0[r]; for (int r = 0; r < 16; ++r) ps += p1[r];
  { auto rr = __builtin_amdgcn_permlane32_swap(__float_as_uint(ps), __float_as_uint(ps), false, false);
    ps = __uint_as_float(rr[0]) + __uint_as_float(rr[1]); }
  l_reg = l_reg * alpha + ps;
#define PK4(P, BASE, OUT) do { unsigned a0 = cvt_pk_bf16(P[BASE + 0], P[BASE + 1]), a1 = cvt_pk_bf16(P[BASE + 2], P[BASE + 3]);   \
    unsigned b0 = cvt_pk_bf16(P[BASE + 4], P[BASE + 5]), b1 = cvt_pk_bf16(P[BASE + 6], P[BASE + 7]);                              \
    auto r0 = __builtin_amdgcn_permlane32_swap(a0, b0, false, false); auto r1 = __builtin_amdgcn_permlane32_swap(a1, b1, false, false); \
    u32x4 w = {r0[0], r1[0], r0[1], r1[1]}; OUT = *reinterpret_cast<bf16x8*>(&w); } while (0)
  PK4(p0, 0, pa0); PK4(p0, 8, pa1); PK4(p1, 0, pa2); PK4(p1, 8, pa3);
#undef PK4
}
__device__ __forceinline__ void qkt(f32x16& p0, f32x16& p1, const bf16_t* Ks, const bf16x8* qr, int r32, int hi) {
  p0 = f32x16{}; p1 = f32x16{};
  for (int d0 = 0; d0 < 8; ++d0) { int cb = (d0 * 16 + hi * 8) * 2;
    bf16x8 b0 = *reinterpret_cast<const bf16x8*>((const char*)Ks + KSWZ(r32, cb));
    bf16x8 b1 = *reinterpret_cast<const bf16x8*>((const char*)Ks + KSWZ(32 + r32, cb));
    p0 = __builtin_amdgcn_mfma_f32_32x32x16_bf16(b0, qr[d0], p0, 0, 0, 0);
    p1 = __builtin_amdgcn_mfma_f32_32x32x16_bf16(b1, qr[d0], p1, 0, 0, 0); }
}
__device__ __forceinline__ int v_st(int k, int c) { const int kk = (k & ~0xC) | ((k & 4) << 1) | ((k & 8) >> 1); return ((kk >> 3) * 4 + (c >> 5)) * 512 + ((kk & 7) * 32 + (c & 31)) * 2; }
__device__ __forceinline__ int v_rd_base(int lane) { return ((lane & 3) << 3) | (((lane >> 2) & 3) << 6) | (((lane >> 4) & 1) << 5) | (((lane >> 5) & 1) << 8); }
constexpr int v_rd_off(int d0, int ks, int half) { return d0 * 512 + ks * 4096 + half * 2048; }
template <int OFF> __device__ __forceinline__ s16x4 tr_read(int vb) {
  s16x4 r; asm volatile("ds_read_b64_tr_b16 %0, %1 offset:%2" : "=&v"(r) : "v"(vb), "i"(OFF) : "memory"); return r;
}
template <int D0> __device__ __forceinline__ void pv_one(f32x16& od, int vb, bf16x8 pa0, bf16x8 pa1, bf16x8 pa2, bf16x8 pa3) {
  const s16x4 l0 = tr_read<v_rd_off(D0, 0, 0)>(vb), h0 = tr_read<v_rd_off(D0, 0, 1)>(vb), l1 = tr_read<v_rd_off(D0, 1, 0)>(vb), h1 = tr_read<v_rd_off(D0, 1, 1)>(vb);
  const s16x4 l2 = tr_read<v_rd_off(D0, 2, 0)>(vb), h2 = tr_read<v_rd_off(D0, 2, 1)>(vb), l3 = tr_read<v_rd_off(D0, 3, 0)>(vb), h3 = tr_read<v_rd_off(D0, 3, 1)>(vb);
  asm volatile("s_waitcnt lgkmcnt(0)" ::: "memory"); SBAR();
#define PK(L, H) (bf16x8){L[0], L[1], L[2], L[3], H[0], H[1], H[2], H[3]}
  od = __builtin_amdgcn_mfma_f32_32x32x16_bf16(pa0, PK(l0, h0), od, 0, 0, 0);
  od = __builtin_amdgcn_mfma_f32_32x32x16_bf16(pa1, PK(l1, h1), od, 0, 0, 0);
  od = __builtin_amdgcn_mfma_f32_32x32x16_bf16(pa2, PK(l2, h2), od, 0, 0, 0);
  od = __builtin_amdgcn_mfma_f32_32x32x16_bf16(pa3, PK(l3, h3), od, 0, 0, 0);
#undef PK
}
__device__ __forceinline__ void pv_d0(f32x16* o, int vb, bf16x8 pa0, bf16x8 pa1, bf16x8 pa2, bf16x8 pa3) {
  pv_one<0>(o[0], vb, pa0, pa1, pa2, pa3); pv_one<1>(o[1], vb, pa0, pa1, pa2, pa3); pv_one<2>(o[2], vb, pa0, pa1, pa2, pa3); pv_one<3>(o[3], vb, pa0, pa1, pa2, pa3);
}
__device__ __forceinline__ void attn_dense_body(const bf16_t* __restrict__ Qb, const bf16_t* __restrict__ Kh, const bf16_t* __restrict__ Vh,
                                                bf16_t* __restrict__ Ob, const bf16_t* __restrict__ Gb, int seq, char* lds, int wid) {
  int lane = lane_id(); asm volatile("" : "+v"(lane));
  const int tid = wid * 64 + lane, r32 = lane & 31, hi = lane >> 5;
  bf16_t* V_lds = (bf16_t*)lds; bf16_t* K_lds = (bf16_t*)(lds + 2 * SHM_V);
  float* ws = (float*)(lds + 2 * SHM_V + 2 * SHM_K) + wid * 64; float* li_l = ws; float* al_l = ws + 32;
  float m_reg = -1e30f, l_reg = 0; f32x16 o[4] = {}; bf16x8 qr[8];
  const unsigned char* Qw = (const unsigned char*)Qb + (long)(wid * QBLK + r32) * LDQ + hi * 8;
#pragma unroll
  for (int d0 = 0; d0 < 8; ++d0) { const u32x2 w8 = *reinterpret_cast<const u32x2*>(Qw + d0 * 16); f32x4 q0, q1; pg8::unpack8f8(w8, q0, q1); qr[d0] = __builtin_bit_cast(bf16x8, pg8::pack8(q0, q1)); }
  const int sr = tid >> 4, sc = (tid & 15) * 8, vst0 = v_st(sr, sc), vst1 = v_st(32 + sr, sc);
  const int vb0 = (int)(uintptr_t)V_lds + v_rd_base(lane);
  struct { bf16x8 vs0, vs1, ks0, ks1; } sr_[2];
#define SLOAD(i, k0) do { sr_[i].vs0 = *reinterpret_cast<const bf16x8*>(&Vh[(long)((k0) + sr) * LDK + sc]); sr_[i].vs1 = *reinterpret_cast<const bf16x8*>(&Vh[(long)((k0) + 32 + sr) * LDK + sc]); \
    sr_[i].ks0 = *reinterpret_cast<const bf16x8*>(&Kh[(long)((k0) + sr) * LDK + sc]); sr_[i].ks1 = *reinterpret_cast<const bf16x8*>(&Kh[(long)((k0) + 32 + sr) * LDK + sc]); } while (0)
#define SWRITE(b, i) do { *(bf16x8*)((char*)V_lds + (b) * SHM_V + vst0) = sr_[i].vs0;          \
    *(bf16x8*)((char*)V_lds + (b) * SHM_V + vst1) = sr_[i].vs1; int kc = sc * 2;               \
    *(bf16x8*)((char*)K_lds + (b) * SHM_K + KSWZ(sr, kc)) = sr_[i].ks0;                       \
    *(bf16x8*)((char*)K_lds + (b) * SHM_K + KSWZ(32 + sr, kc)) = sr_[i].ks1; } while (0)
#define SWAIT() asm volatile("s_waitcnt vmcnt(4)" ::: "memory")
#define RESC(a) do { if (__any((a) < 1.f)) { if (hi == 0) al_l[r32] = (a); asm volatile("s_waitcnt lgkmcnt(0)" ::: "memory"); \
    for (int d = 0; d < 4; ++d) for (int r = 0; r < 16; ++r) o[d][r] *= al_l[crow(r, hi)]; } } while (0)
  f32x16 pA0, pA1, pB0, pB1; float mnA, mnB, alA, alB; bf16x8 pa0, pa1, pa2, pa3; const int NT = seq / KVBLK;
  constexpr int SE = 0, SO = 1;
  SLOAD(SE, 0); asm volatile("s_waitcnt vmcnt(0)" ::: "memory"); SWRITE(0, SE); __syncthreads();
  qkt(pA0, pA1, K_lds, qr, r32, hi); partialSM(pA0, pA1, m_reg, mnA, alA);
  SLOAD(SO, KVBLK); if (2 < NT) SLOAD(SE, 2 * KVBLK);
  SWAIT(); SWRITE(1, SO); __syncthreads();
  for (int j = 1; j + 1 < NT; j += 2) {
    SBAR(); qkt(pB0, pB1, (bf16_t*)((char*)K_lds + SHM_K), qr, r32, hi);
    finishSM(pA0, pA1, alA, l_reg, pa0, pa1, pa2, pa3); SBAR();
    SLOAD(SO, (j + 2) * KVBLK); SBAR();
    pv_d0(o, vb0, pa0, pa1, pa2, pa3); partialSM(pB0, pB1, m_reg, mnB, alB);
    __syncthreads(); SWAIT(); SWRITE(0, SE);
    RESC(alB); __syncthreads();
    SBAR(); qkt(pA0, pA1, K_lds, qr, r32, hi);
    finishSM(pB0, pB1, alB, l_reg, pa0, pa1, pa2, pa3); SBAR();
    if (j + 3 < NT) SLOAD(SE, (j + 3) * KVBLK); SBAR();
    pv_d0(o, vb0 + (int)SHM_V, pa0, pa1, pa2, pa3); partialSM(pA0, pA1, m_reg, mnA, alA);
    __syncthreads(); SWAIT(); SWRITE(1, SO);
    RESC(alA); __syncthreads();
  }
  SBAR(); qkt(pB0, pB1, (bf16_t*)((char*)K_lds + SHM_K), qr, r32, hi);
  finishSM(pA0, pA1, alA, l_reg, pa0, pa1, pa2, pa3); SBAR();
  pv_d0(o, vb0, pa0, pa1, pa2, pa3); partialSM(pB0, pB1, m_reg, mnB, alB);
  __syncthreads(); RESC(alB);
  finishSM(pB0, pB1, alB, l_reg, pa0, pa1, pa2, pa3); SBAR();
  pv_d0(o, vb0 + (int)SHM_V, pa0, pa1, pa2, pa3);
  if (hi == 0) li_l[r32] = l_reg; asm volatile("s_waitcnt lgkmcnt(0)" ::: "memory");
  { const int jq = (r32 & 3) * 32 + (r32 & ~3); const unsigned sel = (unsigned)(r32 & 3) | ((4u + (unsigned)(r32 & 3)) << 8) | 0x0c0c0000u;
    auto quad_tr = [&](unsigned w) -> unsigned {
      const unsigned w0 = (unsigned)__builtin_amdgcn_mov_dpp((int)w, 0x00, 0xF, 0xF, true), w1 = (unsigned)__builtin_amdgcn_mov_dpp((int)w, 0x55, 0xF, 0xF, true);
      const unsigned w2 = (unsigned)__builtin_amdgcn_mov_dpp((int)w, 0xAA, 0xF, 0xF, true), w3 = (unsigned)__builtin_amdgcn_mov_dpp((int)w, 0xFF, 0xF, 0xF, true);
      return __builtin_amdgcn_perm(w1, w0, sel) | (__builtin_amdgcn_perm(w3, w2, sel) << 16); };
    GAS char* op = (GAS char*)Ob + (long)(wid * QBLK + 4 * hi) * LDO * 2 + jq; const GAS char* gp = (const GAS char*)Gb + (long)(wid * QBLK + 4 * hi) * LDG * 2 + jq;
    unsigned gq[16];
#pragma unroll
    for (int r = 0; r < 16; ++r) { gq[r] = *(const GAS unsigned*)gp;
      gp += (long)(((r & 3) == 3) ? 5 : 1) * LDG * 2; asm volatile("" : "+v"(gp)); }
#pragma unroll
    for (int r = 0; r < 16; ++r) { const float rl = __builtin_amdgcn_rcpf(li_l[crow(r, hi)]) * 64.f; const int g = (int)quad_tr(gq[r]);
      const unsigned w = pk_fp8x4(o[0][r] * rl * __builtin_amdgcn_cvt_f32_fp8(g, 0), o[1][r] * rl * __builtin_amdgcn_cvt_f32_fp8(g, 1), o[2][r] * rl * __builtin_amdgcn_cvt_f32_fp8(g, 2), o[3][r] * rl * __builtin_amdgcn_cvt_f32_fp8(g, 3));
      *(GAS unsigned*)op = quad_tr(w);
      op += (long)(((r & 3) == 3) ? 5 : 1) * LDO * 2;
      asm volatile("" : "+v"(op) :: "memory"); } }
  __syncthreads();
#undef SLOAD
#undef SWRITE
#undef SWAIT
#undef RESC
}
#undef KSWZ
#undef SBAR
}

#define XB_TMO      128
#define XB_XCNT(j)  (256  + 64 * (j))
#define XB_XSUB(j)  (1280 + 64 * (j))
#define XB_XGEN(j)  (2304 + 64 * (j))
#define XB_TOP      3328
#define XB_TOPGEN   3392
#define XCD_BAR_WORDS 3456
#define XB_SPIN_CAP (1u << 18)
__device__ __forceinline__ unsigned xb_ld(unsigned* p)              { return __hip_atomic_load(p, __ATOMIC_RELAXED, __HIP_MEMORY_SCOPE_AGENT); }
__device__ __forceinline__ unsigned xb_add(unsigned* p, unsigned v) { return __hip_atomic_fetch_add(p, v, __ATOMIC_RELAXED, __HIP_MEMORY_SCOPE_AGENT); }
__device__ __forceinline__ unsigned xb_xcc_id() { return (unsigned)__builtin_amdgcn_s_getreg((3 << 11) | 20) & 0xFu; }
#define XB_SPIN(cond, bar) do { unsigned _sp = 0; while (cond) { __builtin_amdgcn_s_sleep(1); \
    if ((++_sp & 255u) == 0u) { if (xb_ld(&(bar)[XB_TMO])) break; if (_sp > XB_SPIN_CAP) { atomicAdd(&(bar)[XB_TMO], 1u); break; } } } } while (0)
struct XcdBarrier { unsigned* bar; unsigned x; volatile LAS unsigned* st; };
__device__ __forceinline__ XcdBarrier xcd_barrier_post(unsigned* bar, volatile LAS unsigned* st) {
    XcdBarrier b; b.bar = bar; b.x = (unsigned)__builtin_amdgcn_readfirstlane((int)xb_xcc_id()); b.st = st;
    if (threadIdx.x == 0) (void)xb_add(&bar[XB_XCNT(b.x)], 1u);
    return b;
}
__device__ __forceinline__ void xcd_barrier_complete(unsigned* bar, unsigned x, unsigned& nloc, unsigned& nx) {
    const unsigned G = gridDim.x * gridDim.y * gridDim.z;
    unsigned sum, cnt, mine, sp = 0u;
    for (;;) {
        sum = 0u; cnt = 0u; mine = 0u;
#pragma unroll
        for (unsigned j = 0; j < 16; ++j) { const unsigned c = xb_ld(&bar[XB_XCNT(j)]); sum += c; cnt += (c > 0u) ? 1u : 0u; mine = (j == x) ? c : mine; }
        if (sum == G) break;
        __builtin_amdgcn_s_sleep(1);
        if ((++sp & 255u) == 0u) { if (xb_ld(&bar[XB_TMO])) break; if (sp > XB_SPIN_CAP) { atomicAdd(&bar[XB_TMO], 1u); break; } }
    }
    nloc = mine > 0u ? mine : 1u; nx = cnt > 0u ? cnt : 1u;
}
__device__ __forceinline__ void xcd_barrier(const XcdBarrier& b) {
    asm volatile("s_waitcnt vmcnt(0)" ::: "memory");
    __syncthreads();
    if (threadIdx.x == 0) {
        unsigned* bar = b.bar; unsigned bx_ = b.x; asm volatile("" : "+s"(bar), "+s"(bx_));
        __builtin_amdgcn_s_waitcnt(0);
        unsigned nloc = b.st[0], nx = b.st[1];
        if (nloc == 0u) { xcd_barrier_complete(bar, bx_, nloc, nx); b.st[0] = nloc; b.st[1] = nx; }
        const unsigned old = xb_add(&bar[XB_XSUB(bx_)], 1u);
        const unsigned gen = old / nloc;
        if (old + 1u == (gen + 1u) * nloc) {
            __builtin_amdgcn_fence(__ATOMIC_RELEASE, "agent");
            asm volatile("s_waitcnt vmcnt(0)" ::: "memory");
            const unsigned og = xb_add(&bar[XB_TOP], 1u);
            const unsigned tg = og / nx;
            if (og + 1u == (tg + 1u) * nx) xb_add(&bar[XB_TOPGEN], 1u);
            else XB_SPIN(xb_ld(&bar[XB_TOPGEN]) == tg, bar);
            __builtin_amdgcn_fence(__ATOMIC_ACQUIRE, "agent");
            xb_add(&bar[XB_XGEN(bx_)], 1u);
            asm volatile("s_waitcnt vmcnt(0)" ::: "memory");
        } else {
            XB_SPIN(xb_ld(&bar[XB_XGEN(bx_)]) == gen, bar);
            __builtin_amdgcn_fence(__ATOMIC_ACQUIRE, "agent");
            asm volatile("s_waitcnt vmcnt(0)" ::: "memory");
        }
    }
    __syncthreads();
}

constexpr int NWAVES = 8;
constexpr int RING_BYTES = 131072, MISC_OFF = RING_BYTES + 320, LDS_BYTES = 147456;
constexpr int CW_BAR = 4096;
constexpr int CW_Q = 8192;
constexpr int N_PHASES = 17;

typedef const float GAS* gfp_t; typedef const gfp_t __attribute__((address_space(4)))* kargp_t;
struct KargTab { kargp_t p; __device__ __forceinline__ const float* operator[](int k) const { return (const float*)p[k]; } };
struct Args { const float* in[27]; float* out; unsigned char* ws; int ph_lo, ph_hi; };

enum { I_XP = 0, I_XS, I_CK, I_CV, I_C, I_CCTX, I_WMOD, I_BMOD, I_GPRE, I_WIN, I_QN, I_KN, I_HSW, I_HSB, I_HW1, I_HB1, I_HW2, I_HB2, I_HW3, I_HB3, I_HFR, I_HBIAS, I_WAO, I_WFO, I_WHO, I_WOUT, I_GPOST };

__device__ __forceinline__ void transpose_item(const float* W, int N, bf16_t* WT, int ldt, int koff, LAS float* scr, int item, int lane, unsigned char* w8 = nullptr, int n8off = 0, float s8 = 64.f) {
    const int nblk = N / 64, kb = item / nblk, nb = item % nblk, k0 = 64 * kb, n0 = 64 * nb;
    const int kq = lane >> 4, nq = lane & 15;
    const float* src = W + (size_t)(k0 + kq) * N + n0 + 4 * nq;
    f32x4 v[16];
#pragma unroll
    for (int i = 0; i < 16; ++i) v[i] = __builtin_nontemporal_load((const f32x4*)(src + (size_t)(4 * i) * N));
#pragma unroll
    for (int i = 0; i < 16; ++i) *(LAS f32x4*)(scr + (4 * i + kq) * 64 + 4 * (nq ^ (i >> 1))) = v[i];
    LDS_WAIT(); asm volatile("" ::: "memory");
    const int c = lane & 7, nn = lane >> 3;
#pragma unroll
    for (int j = 0; j < 8; ++j) { const int n = nn + 8 * j; const LAS float* s = scr + (8 * c) * 64 + (n ^ (4 * c));
        if (w8) { u32x2 o8; o8.x = pk_fp8x4(s[0 * 64] * s8, s[1 * 64] * s8, s[2 * 64] * s8, s[3 * 64] * s8); o8.y = pk_fp8x4(s[4 * 64] * s8, s[5 * 64] * s8, s[6 * 64] * s8, s[7 * 64] * s8);
                  *(u32x2*)(w8 + (size_t)(n0 + n - n8off) * ldt + k0 + 8 * c) = o8; }
        else { u32x4 o; o.x = cvt_pk_bf16(s[0 * 64], s[1 * 64]); o.y = cvt_pk_bf16(s[2 * 64], s[3 * 64]); o.z = cvt_pk_bf16(s[4 * 64], s[5 * 64]); o.w = cvt_pk_bf16(s[6 * 64], s[7 * 64]);
               *(u32x4*)(WT + (size_t)(n0 + n) * ldt + koff + k0 + 8 * c) = o; } }
    LDS_WAIT(); asm volatile("" ::: "memory");
}

constexpr float HY_MIN_DECAY = -15.350567286626973f;
constexpr float HY_MAX_DECAY = -3.0701134573253945f;

__device__ __forceinline__ void prenorm_store(const f32x4 (&v)[16], const float* gpre, const float* mod  , bf16_t* hrow, unsigned char* h8row, int lane) {
    float ss = 0.f;
#pragma unroll
    for (int j = 0; j < 16; ++j) ss += (v[j].x * v[j].x + v[j].y * v[j].y) + (v[j].z * v[j].z + v[j].w * v[j].w);
    const float rs = 1.0f / sqrtf(wave_sum(ss) * (1.f / DM) + EPS);
#pragma unroll
    for (int j = 0; j < 16; ++j) { const int c = 4 * lane + 256 * j;
        const f32x4 g = *(const f32x4*)(gpre + c), sh = *(const f32x4*)(mod + c), sc = *(const f32x4*)(mod + DM + c);
        const f32x4 y = (v[j] * rs) * g * (sc + 1.0f) + sh;
        u32x2 w; w.x = cvt_pk_bf16(y.x, y.y); w.y = cvt_pk_bf16(y.z, y.w);
        *(u32x2*)(hrow + c) = w; *(unsigned*)(h8row + c) = pk_fp8x4(y.x, y.y, y.z, y.w); }
}

namespace hy {
constexpr int RV_PER_LAYER = 2 * 1024 * 512 + 2 * 1024 * 4096;
constexpr int LAT_LDS = 17408, ZSEQ = 4352;
__device__ __forceinline__ bf16x8 afragp(const LAS unsigned* p, unsigned sh) {
    const unsigned w0 = p[0], w1 = p[1], w2 = p[2], w3 = p[3], w4 = p[4];
    u32x4 o; o.x = __builtin_amdgcn_alignbit(w1, w0, sh); o.y = __builtin_amdgcn_alignbit(w2, w1, sh); o.z = __builtin_amdgcn_alignbit(w3, w2, sh); o.w = __builtin_amdgcn_alignbit(w4, w3, sh);
    return __builtin_bit_cast(bf16x8, o);
}
__device__ __forceinline__ bf16x8 afrag(const LAS unsigned* rv, int q0) {
    const int e = q0 >> 1; const unsigned sh = (unsigned)(q0 & 1) << 4;
    const unsigned w0 = rv[e], w1 = rv[e + 1], w2 = rv[e + 2], w3 = rv[e + 3], w4 = rv[e + 4];
    u32x4 o; o.x = __builtin_amdgcn_alignbit(w1, w0, sh); o.y = __builtin_amdgcn_alignbit(w2, w1, sh); o.z = __builtin_amdgcn_alignbit(w3, w2, sh); o.w = __builtin_amdgcn_alignbit(w4, w3, sh);
    return __builtin_bit_cast(bf16x8, o);
}
struct ScW { float w0, w1, w2, b; };
__device__ __forceinline__ ScW scw(const float* sw, const float* sb, int uc) { ScW w; w.w0 = sw[uc]; w.w1 = sw[3072 + uc]; w.w2 = sw[6144 + uc]; w.b = sb[uc]; return w; }
__device__ __forceinline__ f32x4 bf4(u32x2 w) { return (f32x4){bf2f(w.x & 0xffffu), bf2f(w.x >> 16), bf2f(w.y & 0xffffu), bf2f(w.y >> 16)}; }
typedef unsigned char u8_t;
__device__ __forceinline__ float f8f(unsigned b) { return __builtin_amdgcn_cvt_f32_fp8((int)b, 0); }
struct __attribute__((packed, aligned(4))) U3a4 { unsigned a, b, c; };
struct __attribute__((packed, aligned(4))) U4a4 { unsigned a, b, c, d; };
__device__ __forceinline__ f32x4 sc4(const u8_t* p, bool has_prev, bool has_next, const ScW w) {
    const U3a4 r = *(const U3a4*)(p - 4); const auto lo = __builtin_amdgcn_cvt_pk_f32_fp8((int)r.b, false), hi = __builtin_amdgcn_cvt_pk_f32_fp8((int)r.b, true);
    const f32x4 x = {lo[0], lo[1], hi[0], hi[1]}; const float pv = has_prev ? __builtin_amdgcn_cvt_f32_fp8((int)r.a, 3) : 0.f, nx = has_next ? __builtin_amdgcn_cvt_f32_fp8((int)r.c, 0) : 0.f;
    return (f32x4){w.b + w.w0 * pv + w.w1 * x[0] + w.w2 * x[1], w.b + w.w0 * x[0] + w.w1 * x[1] + w.w2 * x[2], w.b + w.w0 * x[1] + w.w1 * x[2] + w.w2 * x[3], w.b + w.w0 * x[2] + w.w1 * x[3] + w.w2 * nx};
}
__device__ __forceinline__ bf16x8 sc8(const u8_t* p, bool has_prev, bool has_next, const ScW w) {
    const U4a4 r = *(const U4a4*)(p - 4); const float pv = has_prev ? __builtin_amdgcn_cvt_f32_fp8((int)r.a, 3) : 0.f, nx = has_next ? __builtin_amdgcn_cvt_f32_fp8((int)r.d, 0) : 0.f;
    const auto a0 = __builtin_amdgcn_cvt_pk_f32_fp8((int)r.b, false), a1 = __builtin_amdgcn_cvt_pk_f32_fp8((int)r.b, true), b0 = __builtin_amdgcn_cvt_pk_f32_fp8((int)r.c, false), b1 = __builtin_amdgcn_cvt_pk_f32_fp8((int)r.c, true);
    const float x[10] = {pv, a0[0], a0[1], a1[0], a1[1], b0[0], b0[1], b1[0], b1[1], nx}; float y[8];
#pragma unroll
    for (int e = 0; e < 8; ++e) y[e] = w.b + w.w0 * x[e] + w.w1 * x[e + 1] + w.w2 * x[e + 2];
    u32x4 o; o.x = cvt_pk_bf16(y[0], y[1]); o.y = cvt_pk_bf16(y[2], y[3]); o.z = cvt_pk_bf16(y[4], y[5]); o.w = cvt_pk_bf16(y[6], y[7]); return __builtin_bit_cast(bf16x8, o);
}
template <int H>
__device__ __forceinline__ void ctx_conv_half(const LAS unsigned* rv, const bf16x8 (&B)[16], f32x16 (&acc)[4], int i, int kh) {
    int base = 255 - i + 8 * kh; asm volatile("" : "+v"(base));
    const LAS unsigned* pb = rv + (base >> 1) - 8 * 14; const unsigned sh = (unsigned)(base & 1) << 4;
#pragma unroll
    for (int m = (H ? -7 : -15); m <= (H ? 14 : 6); ++m) {
        const bf16x8 A = afragp(pb + 8 * (14 - m), sh);
#pragma unroll
        for (int j = 0; j < 4; ++j) { const int js = 2 * (4 * H + j) - m; if (js >= 0 && js < 16) acc[j] = __builtin_amdgcn_mfma_f32_32x32x16_bf16(A, B[js], acc[j], 0, 0, 0); }
        if ((m & 1) == 0) asm volatile("" ::: "memory");
    }
}
#define HY_PK4(P, BASE, OUT) do { unsigned a0 = cvt_pk_bf16(P[BASE + 0], P[BASE + 1]), a1 = cvt_pk_bf16(P[BASE + 2], P[BASE + 3]);   \
    unsigned b0 = cvt_pk_bf16(P[BASE + 4], P[BASE + 5]), b1 = cvt_pk_bf16(P[BASE + 6], P[BASE + 7]);                              \
    auto r0 = __builtin_amdgcn_permlane32_swap(a0, b0, false, false); auto r1 = __builtin_amdgcn_permlane32_swap(a1, b1, false, false); \
    u32x4 w = {r0[0], r1[0], r0[1], r1[1]}; OUT = __builtin_bit_cast(bf16x8, w); } while (0)
template <int H>
__device__ __forceinline__ void ctx_pass1(const LAS unsigned* rv, const bf16x8 (&B)[16], bf16x8 (&B2)[16], const u8_t* x1p, const ScW w1c, int i, int kh) {
    f32x16 acc[4];
#pragma unroll
    for (int j = 0; j < 4; ++j) acc[j] = f32x16{};
    ctx_conv_half<H>(rv, B, acc, i, kh);
#pragma unroll
    for (int j = 0; j < 4; ++j) { const int it = 4 * H + j;
#pragma unroll
        for (int g = 0; g < 4; ++g) { const int ps = 32 * it + 8 * g + 4 * kh; const f32x4 x = sc4(x1p + 32 * it + 8 * g, ps > 0, ps + 4 < 256, w1c);
#pragma unroll
            for (int e = 0; e < 4; ++e) acc[j][4 * g + e] *= x[e]; }
        HY_PK4(acc[j], 0, B2[2 * it]); HY_PK4(acc[j], 8, B2[2 * it + 1]);
        asm volatile("" ::: "memory"); }
}
template <int H>
__device__ __forceinline__ void ctx_pass2(const LAS unsigned* rv, const bf16x8 (&B2)[16], const u8_t* x2p, const ScW w2c, bf16_t* yp, int i, int kh) {
    f32x16 acc[4];
#pragma unroll
    for (int j = 0; j < 4; ++j) acc[j] = f32x16{};
    ctx_conv_half<H>(rv, B2, acc, i, kh);
#pragma unroll
    for (int j = 0; j < 4; ++j) { const int it = 4 * H + j;
#pragma unroll
        for (int g = 0; g < 4; ++g) { const int ps = 32 * it + 8 * g + 4 * kh; const f32x4 x = sc4(x2p + 32 * it + 8 * g, ps > 0, ps + 4 < 256, w2c);
            u32x2 w; w.x = cvt_pk_bf16(acc[j][4 * g] * x[0], acc[j][4 * g + 1] * x[1]); w.y = cvt_pk_bf16(acc[j][4 * g + 2] * x[2], acc[j][4 * g + 3] * x[3]);
            *(u32x2*)(yp + 32 * it + 8 * g) = w; }
        asm volatile("" ::: "memory"); }
}
__device__ __forceinline__ void ctx_task(LAS unsigned char* lw, const bf16_t* rvg, const u8_t* ut, bf16_t* y2, const float* sw, const float* sb, int c, int lane) {
    const int n = lane & 31, kh = lane >> 5;
    LAS unsigned* rv0 = (LAS unsigned*)lw; LAS unsigned* rv1 = (LAS unsigned*)(lw + 1024);
    *(LAS u32x4*)(lw + lane * 16) = *(const u32x4*)(rvg + lane * 8);
    *(LAS u32x4*)(lw + 1024 + lane * 16) = *(const u32x4*)(rvg + (size_t)1024 * 512 + lane * 8);
    const size_t sstr = (size_t)1024 * 256;
    const u8_t* vp = ut + (size_t)n * sstr + 8 * kh;
    bf16x8 B[16], B2[16];
    const ScW wv = scw(sw, sb, c), wx1 = scw(sw, sb, 1024 + c), wx2 = scw(sw, sb, 2048 + c);
#pragma unroll
    for (int js = 0; js < 16; ++js) B[js] = sc8(vp + 16 * js, 16 * js + 8 * kh > 0, 16 * js + 8 * kh + 8 < 256, wv);
    LDS_WAIT(); asm volatile("" ::: "memory");
    const u8_t* x1p = ut + (size_t)32 * sstr + (size_t)n * sstr + 4 * kh;
    ctx_pass1<0>(rv0, B, B2, x1p, wx1, n, kh);
    ctx_pass1<1>(rv0, B, B2, x1p, wx1, n, kh);
    const u8_t* x2p = ut + (size_t)64 * sstr + (size_t)n * sstr + 4 * kh; bf16_t* yp = y2 + (size_t)n * sstr + 4 * kh;
    ctx_pass2<0>(rv1, B2, x2p, wx2, yp, n, kh);
    ctx_pass2<1>(rv1, B2, x2p, wx2, yp, n, kh);
    LDS_WAIT(); asm volatile("" ::: "memory");
}
__device__ __forceinline__ void lat_conv(const LAS unsigned* rv, const LAS unsigned char* zl  , const LAS unsigned char* zz  , f32x16 (&acc)[4], int i, int kh, int a) {
    int base = 2047 - i + 8 * kh; asm volatile("" : "+v"(base));
    const LAS unsigned* pb = rv + (base >> 1); const unsigned sh = (unsigned)(base & 1) << 4;
    bf16x8 ring[8];
#pragma unroll
    for (int m = -127; m <= -121; ++m) ring[(m + 128) & 7] = afragp(pb + 8 * 121 + 8 * (-121 - m), sh);
    const LAS unsigned* pit = pb + 8 * 120 - 56;
    int G = a + 15;
    const LAS unsigned char* zc = ((unsigned)G < 16u) ? zl + 272 * G + 16 * kh : zz;
    u32x4 bnext = *(const LAS u32x4*)(zc + 224);
    for (int ub = -127; ub <= 120; ub += 8) {
        --G; const LAS unsigned char* zn = ((unsigned)G < 16u) ? zl + 272 * G + 16 * kh : zz;
#pragma unroll
        for (int k8 = 0; k8 < 8; ++k8) {
            ring[k8 & 7] = afragp(pit + 8 * (7 - k8), sh);
            const bf16x8 Bf = __builtin_bit_cast(bf16x8, bnext);
            bnext = (k8 < 7) ? *(const LAS u32x4*)(zc + 32 * (6 - k8)) : *(const LAS u32x4*)(zn + 224);
#pragma unroll
            for (int x = 0; x < 4; ++x) acc[x] = __builtin_amdgcn_mfma_f32_32x32x16_bf16(ring[(1 + k8 + 2 * x) & 7], Bf, acc[x], 0, 0, 0);
        }
        pit -= 64; zc = zn;
    }
}
__device__ __forceinline__ void lat_task(LAS unsigned char* lw, const bf16_t* rvg, const u8_t* ut, bf16_t* y2, const float* sw, const float* sb, int c, int lane) {
    const int n = lane & 31, kh = lane >> 5, a = n & 15, sq = n >> 4;
    const ScW wv = scw(sw, sb, c), wx1 = scw(sw, sb, 1024 + c), wx2 = scw(sw, sb, 2048 + c);
    const LAS unsigned char* zz = lw + 16928; { unsigned zr_ = 0u; asm volatile("" : "+v"(zr_)); if (lane < 16) *(LAS u32x4*)(lw + 16928 + lane * 16) = (u32x4){zr_, zr_, zr_, zr_}; }
    LAS unsigned* rv = (LAS unsigned*)(lw + 32); LAS unsigned char* zb = lw + 8224; const LAS unsigned char* zl = zb + sq * ZSEQ;
    const size_t sstr = (size_t)1024 * 2048;
#pragma unroll
    for (int j = 0; j < 8; ++j) *(LAS u32x4*)(lw + 32 + (lane + 64 * j) * 16) = *(const u32x4*)(rvg + (lane + 64 * j) * 8);
#pragma unroll
    for (int s2 = 0; s2 < 2; ++s2)
#pragma unroll
        for (int j = 0; j < 4; ++j) { const int p = 8 * (lane + 64 * j); *(LAS bf16x8*)(zb + s2 * ZSEQ + 2 * p + 16 * (p >> 7)) = sc8(ut + (size_t)s2 * sstr + p, p > 0, p + 8 < 2048, wv); }
    f32x16 acc[4];
#pragma unroll
    for (int x = 0; x < 4; ++x) acc[x] = f32x16{};
    LDS_WAIT(); asm volatile("" ::: "memory");
    lat_conv(rv, zl, zz, acc, n, kh, a);
    LDS_WAIT(); asm volatile("" ::: "memory");
    const u8_t* x1p = ut + (size_t)2 * sstr + (size_t)sq * sstr + 128 * a + 4 * kh;
#pragma unroll
    for (int x = 0; x < 4; ++x)
#pragma unroll
        for (int g = 0; g < 4; ++g) { const int t = 128 * a + 32 * x + 8 * g + 4 * kh; const f32x4 xv = sc4(x1p + 32 * x + 8 * g, t > 0, t + 4 < 2048, wx1);
            u32x2 w; w.x = cvt_pk_bf16(acc[x][4 * g] * xv[0], acc[x][4 * g + 1] * xv[1]); w.y = cvt_pk_bf16(acc[x][4 * g + 2] * xv[2], acc[x][4 * g + 3] * xv[3]);
            *(LAS u32x2*)(zb + sq * ZSEQ + 2 * t + 16 * a) = w; }
#pragma unroll
    for (int j = 0; j < 8; ++j) *(LAS u32x4*)(lw + 32 + (lane + 64 * j) * 16) = *(const u32x4*)(rvg + (size_t)1024 * 4096 + (lane + 64 * j) * 8);
#pragma unroll
    for (int x = 0; x < 4; ++x) acc[x] = f32x16{};
    LDS_WAIT(); asm volatile("" ::: "memory");
    lat_conv(rv, zl, zz, acc, n, kh, a);
    const u8_t* x2p = ut + (size_t)4 * sstr + (size_t)sq * sstr + 128 * a + 4 * kh; bf16_t* yp = y2 + (size_t)sq * sstr + 128 * a + 4 * kh;
#pragma unroll
    for (int x = 0; x < 4; ++x)
#pragma unroll
        for (int g = 0; g < 4; ++g) { const int t = 128 * a + 32 * x + 8 * g + 4 * kh; const f32x4 xv = sc4(x2p + 32 * x + 8 * g, t > 0, t + 4 < 2048, wx2);
            u32x2 w; w.x = cvt_pk_bf16(acc[x][4 * g] * xv[0], acc[x][4 * g + 1] * xv[1]); w.y = cvt_pk_bf16(acc[x][4 * g + 2] * xv[2], acc[x][4 * g + 3] * xv[3]);
            *(u32x2*)(yp + 32 * x + 8 * g) = w; }
    LDS_WAIT(); asm volatile("" ::: "memory");
}
}

#define WIN ((bf16_t*)(ws + WS_WIN))
#define H8 ((unsigned char*)(ws + WS_H8))
#define WIN8 ((unsigned char*)(ws + WS_WIN8))
#define WM ((bf16_t*)(ws + WS_WM))
#define WO ((bf16_t*)(ws + WS_WO))
#define Hb ((bf16_t*)(ws + WS_H))
#define PROJ ((bf16_t*)(ws + WS_PROJ))
#define URC ((bf16_t*)(ws + WS_QKV + 2 * MiB))
#define URL ((bf16_t*)(ws + WS_QKV + 2 * MiB) + (size_t)3 * 32 * 1024 * 256)
#define Qb ((bf16_t*)(ws + WS_Q))
#define KC ((bf16_t*)(ws + WS_KC))
#define VC ((bf16_t*)(ws + WS_VC))
#define KL ((bf16_t*)(ws + WS_KL))
#define VL ((bf16_t*)(ws + WS_VL))
#define BR ((bf16_t*)(ws + WS_BR))
#define UCSC ((bf16_t*)(ws + WS_UCSC))
#define UCSL ((bf16_t*)(ws + WS_UCSL))
#define Y2C ((bf16_t*)(ws + WS_Z1))
#define Y2L ((bf16_t*)(ws + WS_Z1) + (size_t)32 * 1024 * 256)
#define Pb ((float*)(ws + WS_P))
#define MG ((bf16_t*)(ws + WS_MG))
#define Ob ((float*)(ws + WS_O))
#define X1 ((float*)(ws + WS_X1))
#define MODP ((float*)(ws + WS_MODP))
#define MOD ((float*)(ws + WS_MOD))
#define HRAW ((float*)(ws + WS_HRAW))
#define PART ((float*)(ws + WS_PART))
#define INVN ((float*)(ws + WS_INVN))
#define RVT ((bf16_t*)(ws + WS_TT))
#define FNP ((float*)(ws + WS_P))
#define CS ((bf16_t*)(ws + WS_CS))
#define FL256 ((bf16_t*)(ws + WS_FL256))
#define FL2048 ((bf16_t*)(ws + WS_FL2048))
__global__ void __launch_bounds__(NWAVES * 64, 2) mega_fwd(Args args) {
    extern __shared__ __attribute__((aligned(16))) unsigned char lds[];
    LAS unsigned char* const ldsp = (LAS unsigned char*)lds;
    volatile LAS unsigned* const MISC = (volatile LAS unsigned*)(ldsp + MISC_OFF);
    const int wave = __builtin_amdgcn_readfirstlane((int)threadIdx.x >> 6);
    const int G0 = gridDim.x, bx0 = blockIdx.x;
#define PHASE_LOCALS int G = G0, bx = bx0; asm volatile("" : "+s"(G), "+s"(bx)); const int gw = bx * NWAVES + wave, NGW = G * NWAVES, NGT = G * NWAVES * 64; (void)gw; (void)NGW; (void)NGT; int lane = lane_id(); asm volatile("" : "+v"(lane)); GAS unsigned char* ws = (GAS unsigned char*)ws0; asm volatile("" : "+s"(ws)); kargp_t kargp_ = (kargp_t)__builtin_amdgcn_kernarg_segment_ptr(); asm volatile("" : "+s"(kargp_)); const KargTab karg{kargp_};         const int gt = (bx * NWAVES + wave) * 64 + lane; (void)gt;
    unsigned char* const ws0 = args.ws;
    unsigned* const ctl = (unsigned*)(ws0 + WS_CTL);
    for (int u = (int)threadIdx.x; u < (LDS_BYTES - RING_BYTES) / 4; u += NWAVES * 64) ((LAS unsigned*)(ldsp + RING_BYTES))[u] = 0u;
    __syncthreads();
#if MK_PER_PHASE
    XcdBarrier bar; bar.bar = ctl + CW_BAR; bar.x = 0; bar.st = nullptr;
#define GRID_BAR() do { } while (0)
#else
    XcdBarrier bar = xcd_barrier_post(ctl + CW_BAR, MISC + 8);
#define GRID_BAR() xcd_barrier(bar)
#endif
#if MK_PER_PHASE
    const int lo = args.ph_lo, hi = args.ph_hi;
#else
    constexpr int lo = 0, hi = N_PHASES;
#endif
#ifndef PHASE_MASK
#define PHASE_MASK 0x3ff
#endif
#define EN(j) (((PHASE_MASK) >> (j)) & 1)
#ifndef SUB_MASK
#define SUB_MASK 0x7f
#endif
#define SUB(j) (((SUB_MASK) >> (j)) & 1)
#define IN(k) (lo <= (k) && (k) < hi)
#define SEAM(k) do { if (IN(k) && IN((k) + 1)) GRID_BAR(); } while (0)

#define x_prompt (karg[I_XP])
#define x_sample (karg[I_XS])
    float* const out = args.out;
    float* const out_k = out + (size_t)MTOK * DM; float* const out_v = out_k + (size_t)32 * 2 * 256 * 512;
    LAS float* const scr = (LAS float*)(ldsp + wave * 16384);

    if (EN(0) && IN(0)) { PHASE_LOCALS
        {
            constexpr int I_IN = (DM / 64) * (INW / 64), I_AO = (2048 / 64) * (DM / 64), I_FO = (1024 / 64) * (DM / 64), I_OUT = (DM / 64) * (DM / 64);
            constexpr int I_IN2 = I_IN / 2, NBI = INW / 64;
            constexpr int PER_L = I_IN2 + I_AO + 2 * I_FO + I_OUT;
            for (int it = gw; it < 2 * PER_L; it += NGW) {
                const int l = 1 - it / PER_L; int r = it % PER_L;
                if (r < I_IN2) { const int nb = r % NBI, kbp = r / NBI; const bool f8g = nb >= (C_GA / 64), f8a = (nb >= C_AG / 64) && (nb < C_FIN / 64), f8q = nb < 2048 / 64, f8h = (nb >= C_HV / 64) && (nb < C_GA / 64);
                    const float* wsrc = karg[I_WIN] + (size_t)l * DM * INW; unsigned char* w8 = (f8g || f8a || f8q || f8h) ? WIN8 + (size_t)l * N8 * DM : nullptr; const int n8off = f8q ? 0 : f8a ? C_AG - 2048 : f8h ? C_HV - 4096 : C_GA - 8192;
                    const float s8 = f8g ? -64.f * 1.4426950408889634f : 64.f;
                    transpose_item(wsrc, INW, WIN + (size_t)l * INW * DM, DM, 0, scr, (2 * kbp) * NBI + nb, lane, w8, n8off, s8);
                    transpose_item(wsrc, INW, WIN + (size_t)l * INW * DM, DM, 0, scr, (2 * kbp + 1) * NBI + nb, lane, w8, n8off, s8); continue; } r -= I_IN2;
                if (r < I_AO) { transpose_item(karg[I_WAO] + (size_t)l * 2048 * DM, DM, WM + (size_t)l * DM * DM, 2 * DM, 0, scr, r, lane, (unsigned char*)(WM + (size_t)l * DM * DM), 0); continue; } r -= I_AO;
                if (r < I_FO) { transpose_item(karg[I_WFO] + (size_t)l * 1024 * DM, DM, WM + (size_t)l * DM * DM, DM, 2048, scr, r, lane); continue; } r -= I_FO;
                if (r < I_FO) { transpose_item(karg[I_WHO] + (size_t)l * 1024 * DM, DM, WM + (size_t)l * DM * DM, 2 * DM, 0, scr, r, lane, (unsigned char*)(WM + (size_t)l * DM * DM) + 6144, 0); continue; } r -= I_FO;
                transpose_item(karg[I_WOUT] + (size_t)l * DM * DM, DM, WO + (size_t)l * DM * DM, DM, 0, scr, r, lane);
            }
        }
        {
            const float* cctx = karg[I_CCTX]; const float* cc = karg[I_C];
            for (int it = gw; it < 2 * 32 * 48; it += NGW) {
                const int l = it / 1536, r = it % 1536, kc = r / 48, nb = r % 48;
                const float* W = karg[I_WMOD] + ((size_t)l * DM + kc * 128) * 12288 + nb * 256 + lane * 4;
                f32x4 a0 = {0.f, 0.f, 0.f, 0.f}, a1 = a0, a2 = a0;
#pragma unroll 4
                for (int k = 0; k < 128; ++k) {
                    const int kk = kc * 128 + k;
                    const float s0 = silu_f(cctx[kk]), s1 = silu_f(cc[kk]), s2 = silu_f(cc[DM + kk]);
                    const f32x4 w = __builtin_nontemporal_load((const f32x4*)(W + (size_t)k * 12288));
                    a0 += w * s0; a1 += w * s1; a2 += w * s2;
                }
                float* o = MODP + ((size_t)(l * 32 + kc) * 3) * 12288 + nb * 256 + lane * 4;
                *(f32x4*)o = a0; *(f32x4*)(o + 12288) = a1; *(f32x4*)(o + 2 * 12288) = a2;
            }
        }
        {
            LAS float* feats = scr;
            LAS float* hh = scr + 32 * 36;
            for (int it = gw; it < 2 * 72 * 8; it += NGW) {
                const int l = it / 576, r = it % 576, chunk = r >> 3, cb = r & 7;
                const int Lsel = chunk < 8 ? 0 : 1, L = Lsel ? 2048 : 256, p0 = (Lsel ? chunk - 8 : chunk) * 32;
                const float* w1 = karg[I_HW1] + l * 33 * 64; const float* w2 = karg[I_HW2] + l * 64 * 64;
                const float* w3 = karg[I_HW3] + (size_t)l * 64 * 4096; const float* b3 = karg[I_HB3] + l * 4096;
                const float fr = karg[I_HFR][l * 64 + lane] * 0.15915494309189535f;
                const float bb1 = karg[I_HB1][l * 64 + lane], bb2 = karg[I_HB2][l * 64 + lane];
                if (lane < 33) {
                    for (int p = 0; p < 32; ++p) { const int pos = p0 + p; float f;
                        if (lane == 0) f = (float)pos / (float)L;
                        else if (lane <= 16) { const int mm = (pos * lane) % L; f = cospif(2.0f * (float)mm / (float)L); }
                        else { const int mm = (pos * (lane - 16)) % L; f = sinpif(2.0f * (float)mm / (float)L); }
                        feats[p * 36 + lane] = f; }
                }
                LDS_WAIT(); asm volatile("" ::: "memory");
                { float wc1[33];
#pragma unroll
                  for (int i = 0; i < 33; ++i) wc1[i] = w1[i * 64 + lane];
                  for (int p = 0; p < 32; ++p) { float a = bb1;
#pragma unroll
                      for (int i = 0; i < 33; ++i) a = fmaf(feats[p * 36 + i], wc1[i], a);
                      hh[p * 68 + lane] = __builtin_amdgcn_sinf(fr * a); } }
                LDS_WAIT(); asm volatile("" ::: "memory");
                { float wc2[64];
#pragma unroll
                  for (int i = 0; i < 64; ++i) wc2[i] = w2[i * 64 + lane];
                  for (int p = 0; p < 32; ++p) { float a = bb2;
#pragma unroll
                      for (int i4 = 0; i4 < 16; ++i4) { const f32x4 hv = *(const LAS f32x4*)(hh + p * 68 + 4 * i4); a = fmaf(hv[0], wc2[4 * i4], a); a = fmaf(hv[1], wc2[4 * i4 + 1], a); a = fmaf(hv[2], wc2[4 * i4 + 2], a); a = fmaf(hv[3], wc2[4 * i4 + 3], a); }
                      const float h2v = __builtin_amdgcn_sinf(fr * a);
                      asm volatile("s_waitcnt lgkmcnt(0)" ::: "memory");
                      hh[p * 68 + lane] = h2v; } }
                LDS_WAIT(); asm volatile("" ::: "memory");
                const int n = lane & 31, kh = lane >> 5;
                bf16x8 Af[4];
#pragma unroll
                for (int ks = 0; ks < 4; ++ks) { const f32x4 x0 = *(const LAS f32x4*)(hh + n * 68 + 16 * ks + 8 * kh), x1 = *(const LAS f32x4*)(hh + n * 68 + 16 * ks + 8 * kh + 4);
                    u32x4 w; w.x = cvt_pk_bf16(x0[0], x0[1]); w.y = cvt_pk_bf16(x0[2], x0[3]); w.z = cvt_pk_bf16(x1[0], x1[1]); w.w = cvt_pk_bf16(x1[2], x1[3]); Af[ks] = __builtin_bit_cast(bf16x8, w); }
                const float invL = 1.0f / (float)L;
                for (int nt = 0; nt < 16; ++nt) {
                    const int col = cb * 512 + nt * 32 + n; const float* wp = w3 + (size_t)(8 * kh) * 4096 + col;
                    f32x16 acc = f32x16{};
#pragma unroll
                    for (int ks = 0; ks < 4; ++ks) { float wv[8];
#pragma unroll
                        for (int e = 0; e < 8; ++e) wv[e] = wp[(size_t)(16 * ks + e) * 4096];
                        u32x4 w; w.x = cvt_pk_bf16(wv[0], wv[1]); w.y = cvt_pk_bf16(wv[2], wv[3]); w.z = cvt_pk_bf16(wv[4], wv[5]); w.w = cvt_pk_bf16(wv[6], wv[7]);
                        acc = __builtin_amdgcn_mfma_f32_32x32x16_bf16(Af[ks], __builtin_bit_cast(bf16x8, w), acc, 0, 0, 0); }
                    const float bias = b3[col]; const float dl = fabsf(HY_MIN_DECAY + (float)(col & 1023) * ((HY_MAX_DECAY - HY_MIN_DECAY) / 1023.0f)) * 1.4426950408889634f;
                    float* hr = HRAW + ((size_t)l * 2304 + chunk * 32) * 4096 + col; float ps = 0.f;
#pragma unroll
                    for (int rr = 0; rr < 16; ++rr) { const int prow = (rr & 3) + 8 * (rr >> 2) + 4 * kh; const float t = (float)(p0 + prow) * invL;
                        const float v = (acc[rr] + bias) * __builtin_amdgcn_exp2f(-t * dl); ps += fabsf(v); hr[(size_t)prow * 4096] = v; }
                    { auto sw = __builtin_amdgcn_permlane32_swap(__float_as_uint(ps), __float_as_uint(ps), false, false); ps = __uint_as_float(sw[0]) + __uint_as_float(sw[1]); }
                    if (lane < 32) PART[((size_t)l * 72 + chunk) * 4096 + col] = ps;
                }
                LDS_WAIT(); asm volatile("" ::: "memory");
            }
        }
        for (int i = gt; i < 512 * 256; i += NGT) { const int r = i >> 8, c = i & 255; const int j = r & 255; const int mm = (j * c) & 255; const float a = 2.0f * (float)mm / 256.0f;
            CS[i] = f2bf((r < 256 ? cospif(a) : sinpif(a)) * 0.0625f); }
        for (int i = gt; i < 256 * 512; i += NGT) { const int t = i >> 9, s = i & 511; const int mm = (t * (s & 255)) & 255; const float a = 2.0f * (float)mm / 256.0f;
            FL256[i] = f2bf((s < 256 ? cospif(a) : -sinpif(a)) * 0.0625f); }
        { LAS unsigned* tw = (LAS unsigned*)(ldsp + RING_BYTES + 1024);
          __syncthreads();
          for (int m = wave * 64 + lane; m < 2048; m += NWAVES * 64) { const float a = 2.0f * (float)m / 2048.0f; tw[m] = cvt_pk_bf16(cospif(a) * 0.022097086912079608f, -sinpif(a) * 0.022097086912079608f); }
          __syncthreads();
          for (int i = gt; i < 2048 * 512; i += NGT) { const int t = i >> 9, s0 = (i & 511) * 8; const int hs = s0 >> 11; unsigned e[8];
#pragma unroll
              for (int k = 0; k < 8; ++k) { const unsigned w = tw[(t * ((s0 + k) & 2047)) & 2047]; e[k] = hs ? (w >> 16) : (w & 0xffffu); }
              u32x4 o; o.x = e[0] | (e[1] << 16); o.y = e[2] | (e[3] << 16); o.z = e[4] | (e[5] << 16); o.w = e[6] | (e[7] << 16);
              *(u32x4*)(FL2048 + (size_t)i * 8) = o; }
        }
    }
    SEAM(0);
    if (EN(1) && IN(1)) { PHASE_LOCALS
        for (int i = gt; i < 2 * 3 * 12288; i += NGT) { const int l = i / 36864, r = (i % 36864) / 12288, n = i % 12288;
            float a = karg[I_BMOD][l * 12288 + n];
            for (int kc = 0; kc < 32; ++kc) a += MODP[((size_t)(l * 32 + kc) * 3 + r) * 12288 + n];
            MOD[i] = a; }
        for (int i = gt; i < 8 * 8192; i += NGT) { const int j = i & 8191, sl = i >> 13; const int c = j & 1023, o = (j >> 10) & 1, Lsel = (j >> 11) & 1, l = j >> 12;
            const int c0 = (Lsel ? 8 : 0) + sl, c1 = Lsel ? 72 : 8; float s = 0.f;
#pragma unroll
            for (int k = 0; k < 8; ++k) { const int ch = c0 + 8 * k; if (ch < c1) { const float* p = PART + ((size_t)l * 72 + ch) * 4096 + o * 2048 + c; s += p[0] + p[1024]; } }
            INVN[i] = s; }
    }
    SEAM(1);
    if (EN(2) && IN(2)) { PHASE_LOCALS
        for (int it = gw; it < 2 * 2304; it += NGW) {
            const int l = it / 2304; int r = it % 2304; int Lsel, L;
            if (r < 256) { Lsel = 0; L = 256; } else { Lsel = 1; L = 2048; r -= 256; }
            const int nqb = (2 * L) / 64; const int o = r / (nqb * 16), qb = (r / 16) % nqb, cb = r % 16; const int c = cb * 64 + lane;
            float nsum = EPS;
#pragma unroll
            for (int sl = 0; sl < 8; ++sl) nsum += INVN[sl * 8192 + ((l * 2 + Lsel) * 2 + o) * 1024 + c];
            const float inv = 1.0f / nsum;
            const float* hb = HRAW + ((size_t)l * 2304 + (Lsel ? 256 : 0)) * 4096 + o * 2048 + c;
            const float bias = karg[I_HBIAS][(l * 2 + o) * 1024 + c];
            bf16_t* dst = RVT + (size_t)l * hy::RV_PER_LAYER + (Lsel ? (size_t)2 * 1024 * 512 : 0) + ((size_t)o * 1024 + c) * (2 * L) + qb * 64;
#pragma unroll
            for (int j8 = 0; j8 < 8; ++j8) { float v[8];
#pragma unroll
                for (int e = 0; e < 8; ++e) { const int q = qb * 64 + j8 * 8 + e; const int d = L - 1 - q;
                    float x = 0.f;
                    if (q < 2 * L - 1) { if (d > 0) x = hb[(size_t)d * 4096] * inv; else if (d < 0) x = hb[(size_t)(-d) * 4096 + 1024] * inv; else x = (hb[0] + hb[1024]) * inv + bias; }
                    v[e] = x; }
                u32x4 w; w.x = cvt_pk_bf16(v[0], v[1]); w.y = cvt_pk_bf16(v[2], v[3]); w.z = cvt_pk_bf16(v[4], v[5]); w.w = cvt_pk_bf16(v[6], v[7]);
                *(u32x4*)(dst + j8 * 8) = w; }
        }
        for (int m = gw; m < MTOK; m += NGW) {
            const float* xr = (m < M_CTX) ? x_prompt + (size_t)m * DM : x_sample + (size_t)(m - M_CTX) * DM;
            const int r = (m < M_CTX) ? 0 : 1 + (m - M_CTX) / L_LAT;
            f32x4 v[16];
#pragma unroll
            for (int j = 0; j < 16; ++j) v[j] = __builtin_nontemporal_load((const f32x4*)(xr + 4 * lane + 256 * j));
            prenorm_store(v, karg[I_GPRE], MOD + (size_t)r * 12288, Hb + (size_t)m * DM, H8 + (size_t)m * DM, lane);
        }
    }
    SEAM(2);

    for (int l = 0; l < 2; ++l) {
        const int pb = 3 + 7 * l;
        if (EN(3) && IN(pb + 0)) { PHASE_LOCALS
            const pg8::EpiProj E{PROJ, Qb, KC, VC, KL, VL, URC, URL, out_k, out_v, (LAS float*)(ldsp + RING_BYTES + 1024), l};
            { LAS float* gl = (LAS float*)(ldsp + RING_BYTES + 1024) + 2048; const int t_ = wave * 64 + lane; if (t_ < 256) gl[t_] = (t_ < 128 ? karg[I_QN] + l * 128 : karg[I_KN] + l * 128 - 128)[t_]; }
            __syncthreads();
            const unsigned xq = bar.x & 7u; LAS unsigned* qsl = (LAS unsigned*)(ldsp + RING_BYTES + 16);
            { struct Sched { enum { DYN = 1 }; LAS unsigned* qs; unsigned* ctr0; unsigned x0; const char* A; const char* B; unsigned cnt;
                __device__ __forceinline__ unsigned draw(unsigned q) const { return __hip_atomic_fetch_add(ctr0 + q * 64, 1u, __ATOMIC_RELAXED, __HIP_MEMORY_SCOPE_AGENT); }
                __device__ __forceinline__ unsigned resolve(unsigned off, unsigned q, unsigned& qcur) const { for (int k = 0; k < 8; ++k) { if (off < cnt) return q * cnt + off; q = (q + 1u) & 7u; qcur = q; off = draw(q); } return ~0u; }
                __device__ __forceinline__ bool next(int i, pg8::Unit& u) const { const int id = __builtin_amdgcn_readfirstlane((int)qs[i & 1]); if (id < 0) return false; int pm, pn; pg8::tile_of_id(id, 48, 8, pm, pn);
                    u.a = A + (size_t)pm * 256 * DM; u.b = B + (size_t)pn * 256 * DM; u.K = DM / 2; u.pm = pm; u.pn = pn; u.aux = 0; return true; } };
              const Sched S{qsl, ctl + CW_Q + ((l * 8 + 3) * 8) * 64, xq, (const char*)H8, (const char*)(WIN8 + (size_t)l * N8 * DM), 48u};
              pg8::gemm_phase<1, true>(ldsp, pg8::Gemm{DM / 2, DM / 2}, S, E, wave); }
            { struct Sched { enum { DYN = 1 }; LAS unsigned* qs; unsigned* ctr0; unsigned x0; const char* A; const char* B; unsigned cnt;
                __device__ __forceinline__ unsigned draw(unsigned q) const { return __hip_atomic_fetch_add(ctr0 + q * 64, 1u, __ATOMIC_RELAXED, __HIP_MEMORY_SCOPE_AGENT); }
                __device__ __forceinline__ unsigned resolve(unsigned off, unsigned q, unsigned& qcur) const { for (int k = 0; k < 8; ++k) { if (off < cnt) return q * cnt + off; q = (q + 1u) & 7u; qcur = q; off = draw(q); } return ~0u; }
                __device__ __forceinline__ bool next(int i, pg8::Unit& u) const { const int id = __builtin_amdgcn_readfirstlane((int)qs[i & 1]); if (id < 0) return false; int pm, pn; pg8::tile_of_id(id, 48, 2, pm, pn); pn += 8;
                    u.a = A + (size_t)pm * 256 * DM * 2; u.b = B + (size_t)pn * 256 * DM * 2; u.K = DM; u.pm = pm; u.pn = pn; u.aux = 0; return true; } };
              const Sched S{qsl, ctl + CW_Q + ((l * 8 + 0) * 8) * 64, xq, (const char*)Hb, (const char*)(WIN + (size_t)l * INW * DM), 12u};
              pg8::gemm_phase<1, false>(ldsp, pg8::Gemm{DM, DM}, S, E, wave); }
            { struct Sched { enum { DYN = 1 }; LAS unsigned* qs; unsigned* ctr0; unsigned x0; const char* A; const char* B; unsigned cnt;
                __device__ __forceinline__ unsigned draw(unsigned q) const { return __hip_atomic_fetch_add(ctr0 + q * 64, 1u, __ATOMIC_RELAXED, __HIP_MEMORY_SCOPE_AGENT); }
                __device__ __forceinline__ unsigned resolve(unsigned off, unsigned q, unsigned& qcur) const { for (int k = 0; k < 8; ++k) { if (off < cnt) return q * cnt + off; q = (q + 1u) & 7u; qcur = q; off = draw(q); } return ~0u; }
                __device__ __forceinline__ bool next(int i, pg8::Unit& u) const { const int id = __builtin_amdgcn_readfirstlane((int)qs[i & 1]); if (id < 0) return false; int pm, pn; pg8::tile_of_id(id, 48, 10, pm, pn); pn = pn < 2 ? pn + 10 : pn + 18;
                    const char* ta = A + (size_t)pm * 256 * DM * 2; const char* tb = B + (size_t)pn * 256 * DM * 2; const bool swp = (pn >= 28 && pn < 40);
                    u.a = swp ? tb : ta; u.b = swp ? ta : tb; u.K = DM; u.pm = pm; u.pn = pn; u.aux = 0; return true; } };
              const Sched S{qsl, ctl + CW_Q + ((l * 8 + 1) * 8) * 64, xq, (const char*)Hb, (const char*)(WIN + (size_t)l * INW * DM), 60u};
              pg8::gemm_phase<0, false>(ldsp, pg8::Gemm{DM, DM}, S, pg8::EpiRest{PROJ, VC, VL, URC, URL, out_v, l}, wave); }
            { struct Sched { enum { DYN = 1 }; LAS unsigned* qs; unsigned* ctr0; unsigned x0; const char* A; const char* B; unsigned cnt;
                __device__ __forceinline__ unsigned draw(unsigned q) const { return __hip_atomic_fetch_add(ctr0 + q * 64, 1u, __ATOMIC_RELAXED, __HIP_MEMORY_SCOPE_AGENT); }
                __device__ __forceinline__ unsigned resolve(unsigned off, unsigned q, unsigned& qcur) const { for (int k = 0; k < 8; ++k) { if (off < cnt) return q * cnt + off; q = (q + 1u) & 7u; qcur = q; off = draw(q); } return ~0u; }
                __device__ __forceinline__ bool next(int i, pg8::Unit& u) const { const int id = __builtin_amdgcn_readfirstlane((int)qs[i & 1]); if (id < 0) return false; int pm, pn; pg8::tile_of_id(id, 48, 24, pm, pn);
                    const char* ta = A + (size_t)pm * 256 * DM; const char* tb = B + (size_t)(pn + 8) * 256 * DM; pn = pn < 8 ? pn + 12 : pn + 20;
                    const bool swp = (pn >= 28 && pn < 40);
                    u.a = swp ? tb : ta; u.b = swp ? ta : tb; u.K = DM / 2; u.pm = pm; u.pn = pn; u.aux = 0; return true; } };
              const Sched S{qsl, ctl + CW_Q + ((l * 8 + 2) * 8) * 64, xq, (const char*)H8, (const char*)(WIN8 + (size_t)l * N8 * DM), 144u};
              pg8::gemm_phase<3, true>(ldsp, pg8::Gemm{DM / 2, DM / 2}, S, pg8::EpiSig{PROJ, URC, URL}, wave); }
            { struct Sched { enum { DYN = 1 }; LAS unsigned* qs; unsigned* ctr0; unsigned x0; const char* A; const char* B; unsigned cnt;
                __device__ __forceinline__ unsigned draw(unsigned q) const { return __hip_atomic_fetch_add(ctr0 + q * 64, 1u, __ATOMIC_RELAXED, __HIP_MEMORY_SCOPE_AGENT); }
                __device__ __forceinline__ unsigned resolve(unsigned off, unsigned q, unsigned& qcur) const { for (int k = 0; k < 8; ++k) { if (off < cnt) return q * cnt + off; q = (q + 1u) & 7u; qcur = q; off = draw(q); } return ~0u; }
                __device__ __forceinline__ bool next(int i, pg8::Unit& u) const { const int id = __builtin_amdgcn_readfirstlane((int)qs[i & 1]); if (id < 0) return false; int pm, pn; pg8::tile_of_id(id, 48, 16, pm, pn);
                    u.a = A + (size_t)pm * 256 * DM; u.b = B + (size_t)(pn + 48) * 256 * DM; u.K = DM / 2; u.pm = pm; u.pn = pn + 60; u.aux = 0; return true; } };
              const Sched S{qsl, ctl + CW_Q + ((l * 8 + 4) * 8) * 64, xq, (const char*)H8, (const char*)(WIN8 + (size_t)l * N8 * DM), 96u};
              pg8::gemm_phase<0, true>(ldsp, pg8::Gemm{DM / 2, DM / 2}, S, pg8::EpiT{PROJ}, wave); }
            { struct Sched { enum { DYN = 1 }; LAS unsigned* qs; unsigned* ctr0; unsigned x0; const char* A; const char* B; unsigned cnt;
                __device__ __forceinline__ unsigned draw(unsigned q) const { return __hip_atomic_fetch_add(ctr0 + q * 64, 1u, __ATOMIC_RELAXED, __HIP_MEMORY_SCOPE_AGENT); }
                __device__ __forceinline__ unsigned resolve(unsigned off, unsigned q, unsigned& qcur) const { for (int k = 0; k < 8; ++k) { if (off < cnt) return q * cnt + off; q = (q + 1u) & 7u; qcur = q; off = draw(q); } return ~0u; }
                __device__ __forceinline__ bool next(int i, pg8::Unit& u) const { const int id = __builtin_amdgcn_readfirstlane((int)qs[i & 1]); if (id < 0) return false; int pm, pn; pg8::tile_of_id(id, 48, 32, pm, pn);
                    const int gt = pn < 16 ? pn : pn + 16;
                    u.a = A + (size_t)pm * 256 * DM; u.b = B + (size_t)(gt + 32) * 256 * DM; u.K = DM / 2; u.pm = pm; u.pn = gt + 44; u.aux = 0; return true; } };
              const Sched S{qsl, ctl + CW_Q + ((l * 8 + 5) * 8) * 64, xq, (const char*)H8, (const char*)(WIN8 + (size_t)l * N8 * DM), 192u};
              pg8::gemm_phase<3, true>(ldsp, pg8::Gemm{DM / 2, DM / 2}, S, pg8::EpiT8{PROJ}, wave); }
        }
        SEAM(pb + 0);
        if (EN(4) && IN(pb + 1)) { PHASE_LOCALS
            for (int i = gt; i < 2 * PAST * 512; i += NGT) { const int b = i / (PAST * 512), r = i % (PAST * 512);
                const size_t src = ((size_t)(b * 2 + l) * PAST) * 512 + r; const size_t dst = ((size_t)b * KV_LAT + L_LAT) * 512 + r;
                KL[dst] = f2bf(karg[I_CK][src]); VL[dst] = f2bf(karg[I_CV][src]); }
            __syncthreads();
            if (SUB(2)) {
                struct Sched { enum { DYN = 0 }; LAS unsigned* qs; unsigned* ctr0; unsigned x0; __device__ __forceinline__ unsigned draw(unsigned) const { return 0u; } __device__ __forceinline__ unsigned resolve(unsigned, unsigned, unsigned&) const { return 0u; } const char* A; const char* B; int G, c, K;
                    __device__ __forceinline__ bool next(int i, pg8::Unit& u) const { const int L = i * G + c; if (L >= 384) return false; const int tt = L >> 3, g = (L >> 1) & 3, pm = L & 1;
                        u.a = A + (size_t)pm * 256 * 256 * 2; u.b = B + ((size_t)tt * 256 * INW + C_FIN + g * 256) * 2; u.K = K; u.pm = pm; u.pn = tt; u.aux = g; return true; } };
                const int k256 = 256;
                const Sched S{nullptr, nullptr, 0u, (const char*)CS, (const char*)PROJ, G, bx, k256};
                pg8::gemm_phase(ldsp, pg8::Gemm{256, INW}, S, pg8::EpiChan{UCSC, UCSL}, wave);
            }
        }
        SEAM(pb + 1);
        if (EN(5) && IN(pb + 2)) { PHASE_LOCALS
            if (SUB(3)) for (int ui = bx; ui < 768; ui += G) {
                if (ui < 256) { const int b = ui >> 7, h = (ui >> 3) & 15, qb = ui & 7; const size_t row0 = (size_t)M_CTX + b * L_LAT + qb * 256;
                    att::attn_dense_body((const bf16_t*)((const char*)Qb + row0 * 2048 + h * 128), KL + (size_t)b * KV_LAT * 512 + (h >> 2) * 128, VL + (size_t)b * KV_LAT * 512 + (h >> 2) * 128,
                                         (bf16_t*)((char*)(BR + row0 * DM) + h * 128), (const bf16_t*)((const char*)PROJ + row0 * INW * 2 + 2 * C_AG + h * 128), KV_LAT, (char*)lds, wave); }
                else { const int q = ui - 256, b = q >> 4, h = q & 15; const size_t row0 = (size_t)b * L_CTX;
                    att::attn_dense_body((const bf16_t*)((const char*)Qb + row0 * 2048 + h * 128), KC + row0 * 512 + (h >> 2) * 128, VC + row0 * 512 + (h >> 2) * 128,
                                         (bf16_t*)((char*)(BR + row0 * DM) + h * 128), (const bf16_t*)((const char*)PROJ + row0 * INW * 2 + 2 * C_AG + h * 128), L_CTX, (char*)lds, wave); }
            }
            __syncthreads();
            if (SUB(4)) {
                struct Sched { enum { DYN = 0 }; LAS unsigned* qs; unsigned* ctr0; unsigned x0; __device__ __forceinline__ unsigned draw(unsigned) const { return 0u; } __device__ __forceinline__ unsigned resolve(unsigned, unsigned, unsigned&) const { return 0u; } const char* A; const char* B; int G, c;
                    __device__ __forceinline__ bool next(int i, pg8::Unit& u) const { const int L = i * G + c; if (L >= 128) return false; const int sq = L >> 2, pn = L & 3;
                        u.a = A; u.b = B + ((size_t)sq * 1024 + pn * 256) * 512 * 2; u.K = 512; u.pm = sq; u.pn = pn; u.aux = sq * 256; return true; } };
                const Sched S{nullptr, nullptr, 0u, (const char*)FL256, (const char*)UCSC, G, bx};
                pg8::gemm_phase(ldsp, pg8::Gemm{512, 512}, S, pg8::EpiGate{BR, PROJ}, wave);
            }
            if (SUB(5)) {
                struct Sched { enum { DYN = 0 }; LAS unsigned* qs; unsigned* ctr0; unsigned x0; __device__ __forceinline__ unsigned draw(unsigned) const { return 0u; } __device__ __forceinline__ unsigned resolve(unsigned, unsigned, unsigned&) const { return 0u; } const char* A; const char* B; int G, c;
                    __device__ __forceinline__ bool next(int i, pg8::Unit& u) const { const int L = i * G + c; if (L >= 256) return false; const int ks = L & 3, pn = (L >> 2) & 3, pm = (L >> 4) & 7, sq = L >> 7;
                        u.a = A + ((size_t)pm * 256 * 4096 + ks * 1024) * 2; u.b = B + (((size_t)sq * 1024 + pn * 256) * 4096 + ks * 1024) * 2; u.K = 1024; u.pm = sq * 8 + pm; u.pn = pn; u.aux = ks; return true; } };
                const Sched S{nullptr, nullptr, 0u, (const char*)FL2048, (const char*)UCSL, G, bx};
                pg8::gemm_phase(ldsp, pg8::Gemm{4096, 4096}, S, pg8::EpiPart{FNP}, wave);
            }
            if (SUB(6)) {
                const bf16_t* rvl = RVT + (size_t)l * hy::RV_PER_LAYER; const float* hsw = karg[I_HSW] + (size_t)l * 3 * 3072; const float* hsb = karg[I_HSB] + (size_t)l * 3072;
                if (wave < 4) { LAS unsigned char* lw = ldsp + wave * hy::LAT_LDS;
                    for (int c = bx * 4 + wave; c < 1024; c += G * 4) hy::lat_task(lw, rvl + (size_t)2 * 1024 * 512 + (size_t)c * 4096, (const unsigned char*)URL + (size_t)c * 2048, Y2L + (size_t)c * 2048, hsw, hsb, c, lane); }
                else { LAS unsigned char* lw = ldsp + 4 * hy::LAT_LDS + (wave - 4) * 2048;
                    for (int c = bx * 4 + (wave - 4); c < 1024; c += G * 4) hy::ctx_task(lw, rvl + (size_t)c * 512, (const unsigned char*)URC + (size_t)c * 256, Y2C + (size_t)c * 256, hsw, hsb, c, lane); }
            }
        }
        SEAM(pb + 2);
        if (EN(6) && IN(pb + 3)) { PHASE_LOCALS
            for (int it = gw; it < 2048 + 1024; it += NGW) {
                int sq, pbk, cb, L; size_t row0; const bf16_t* y2;
                if (it < 2048) { sq = it >> 6; pbk = (it >> 4) & 3; cb = it & 15; L = L_CTX; row0 = (size_t)sq * L_CTX; y2 = Y2C + (size_t)sq * 1024 * 256; }
                else { const int q = it - 2048; sq = q >> 9; pbk = (q >> 4) & 31; cb = q & 15; L = L_LAT; row0 = (size_t)M_CTX + (size_t)sq * L_LAT; y2 = Y2L + (size_t)sq * 1024 * 2048; }
                const int pp = lane & 31, chh = lane >> 5, t0 = pbk * 64 + 2 * pp; const bf16_t* src = y2 + (size_t)(cb * 64 + chh * 32) * L + t0;
                const unsigned char* gp = (const unsigned char*)PROJ + (row0 + t0) * INW * 2 + 2 * C_HG + cb * 64 + chh * 32; unsigned char* dst = (unsigned char*)(BR + (row0 + t0) * DM) + 6144 + cb * 64 + chh * 32;
                unsigned raw[32];
#pragma unroll
                for (int c = 0; c < 32; ++c) raw[c] = *(const unsigned*)(src + (size_t)c * L);
#pragma unroll
                for (int q = 0; q < 2; ++q) { const u32x4 g0 = *(const u32x4*)(gp + (size_t)q * INW * 2), g1 = *(const u32x4*)(gp + (size_t)q * INW * 2 + 16); u32x4 o0, o1;
#pragma unroll
                    for (int c4 = 0; c4 < 8; ++c4) { const int gw_ = (int)(c4 < 4 ? g0[c4] : g1[c4 - 4]); float y[4];
#pragma unroll
                        for (int e = 0; e < 4; ++e) y[e] = bf2f(q ? (raw[4 * c4 + e] >> 16) : (raw[4 * c4 + e] & 0xffffu)) * 64.f;
                        const unsigned w = pk_fp8x4(y[0] * __builtin_amdgcn_cvt_f32_fp8(gw_, 0), y[1] * __builtin_amdgcn_cvt_f32_fp8(gw_, 1), y[2] * __builtin_amdgcn_cvt_f32_fp8(gw_, 2), y[3] * __builtin_amdgcn_cvt_f32_fp8(gw_, 3));
                        if (c4 < 4) o0[c4] = w; else o1[c4 - 4] = w; }
                    *(u32x4*)(dst + (size_t)q * DM * 2) = o0; *(u32x4*)(dst + (size_t)q * DM * 2 + 16) = o1; }
            }
            for (int i = gt; i < M_LAT * 1024 / 8; i += NGT) { const int r = i >> 7, c = (i & 127) * 8; const size_t row = (size_t)M_CTX + r;
                f32x4 a0 = {0.f, 0.f, 0.f, 0.f}, a1 = a0;
#pragma unroll
                for (int ks = 0; ks < 4; ++ks) { const bf16_t* p = (const bf16_t*)FNP + ((size_t)ks * M_LAT + r) * 1024 + c; f32x4 p0, p1; pg8::unpack8(__builtin_nontemporal_load((const u32x4*)p), p0, p1); a0 += p0; a1 += p1; }
                f32x4 g0, g1; pg8::unpack8(*(const u32x4*)(PROJ + row * INW + C_FG + c), g0, g1);
                *(u32x4*)(BR + row * DM + 2048 + c) = pg8::pack8(a0 * g0, a1 * g1); }
        }
        SEAM(pb + 3);
        if (EN(7) && IN(pb + 4)) { PHASE_LOCALS
            struct Sched { enum { DYN = 0 }; LAS unsigned* qs; unsigned* ctr0; unsigned x0; __device__ __forceinline__ unsigned draw(unsigned) const { return 0u; } __device__ __forceinline__ unsigned resolve(unsigned, unsigned, unsigned&) const { return 0u; } const char* A; const char* B; int G, c;
                __device__ __forceinline__ bool next(int i, pg8::Unit& u) const { const int ti = i / 3, seg = i % 3; const int L = ti * G + c; if (L >= 48 * 16) return false; int pm, pn; pg8::tile_of(L, 48, 16, pm, pn);
                    const int koff = seg == 0 ? 0 : (seg == 1 ? 4096 : 6144);
                    u.a = A + (size_t)pm * 256 * DM * 2 + koff; u.b = B + (size_t)pn * 256 * DM * 2 + koff; u.K = seg == 2 ? 512 : 1024; u.pm = pm; u.pn = pn; u.aux = seg; u.f8 = seg != 1; return true; } };
            const Sched S{nullptr, nullptr, 0u, (const char*)BR, (const char*)(WM + (size_t)l * DM * DM), G, bx};
            pg8::gemm_phase<0, 2>(ldsp, pg8::Gemm{DM, DM}, S, pg8::EpiMerge{MG, PROJ}, wave);
        }
        SEAM(pb + 4);
        if (EN(8) && IN(pb + 5)) { PHASE_LOCALS
            struct Sched { enum { DYN = 0 }; LAS unsigned* qs; unsigned* ctr0; unsigned x0; __device__ __forceinline__ unsigned draw(unsigned) const { return 0u; } __device__ __forceinline__ unsigned resolve(unsigned, unsigned, unsigned&) const { return 0u; } const char* A; const char* B; int G, c;
                __device__ __forceinline__ bool next(int i, pg8::Unit& u) const { const int L = i * G + c; if (L >= 48 * 16) return false; int pm, pn; pg8::tile_of(L, 48, 16, pm, pn);
                    u.a = A + (size_t)pm * 256 * DM * 2; u.b = B + (size_t)pn * 256 * DM * 2; u.K = DM; u.pm = pm; u.pn = pn; u.aux = 0; return true; } };
            const Sched S{nullptr, nullptr, 0u, (const char*)MG, (const char*)(WO + (size_t)l * DM * DM), G, bx};
            pg8::gemm_phase(ldsp, pg8::Gemm{DM, DM}, S, pg8::EpiO16{(bf16_t*)Ob}, wave);
        }
        SEAM(pb + 5);
        if (EN(9) && IN(pb + 6)) { PHASE_LOCALS
            const float* gpost = karg[I_GPOST] + (size_t)l * DM;
            for (int m = gw; m < MTOK; m += NGW) {
                const int r = (m < M_CTX) ? 0 : 1 + (m - M_CTX) / L_LAT;
                const float* xin = (l == 0) ? ((m < M_CTX) ? x_prompt + (size_t)m * DM : x_sample + (size_t)(m - M_CTX) * DM) : X1 + (size_t)m * DM;
                const bf16_t* orow = (const bf16_t*)Ob + (size_t)m * DM; const float* gate = MOD + ((size_t)l * 3 + r) * 12288 + 2 * DM;
                float* xo = (l == 0) ? X1 + (size_t)m * DM : out + (size_t)m * DM;
                f32x4 v[16]; float ss = 0.f;
#pragma unroll
                for (int j = 0; j < 16; ++j) { v[j] = hy::bf4(__builtin_nontemporal_load((const u32x2*)(orow + 4 * lane + 256 * j))); ss += (v[j].x * v[j].x + v[j].y * v[j].y) + (v[j].z * v[j].z + v[j].w * v[j].w); }
                const float rs = 1.0f / sqrtf(wave_sum(ss) * (1.f / DM) + EPS);
#pragma unroll
                for (int j = 0; j < 16; ++j) { const int c = 4 * lane + 256 * j;
                    const f32x4 y = __builtin_nontemporal_load((const f32x4*)(xin + c)) + *(const f32x4*)(gate + c) * ((v[j] * rs) * *(const f32x4*)(gpost + c));
                    __builtin_nontemporal_store(y, (f32x4*)(xo + c)); v[j] = y; }
                if (l == 0) prenorm_store(v, karg[I_GPRE] + DM, MOD + ((size_t)3 + r) * 12288, Hb + (size_t)m * DM, H8 + (size_t)m * DM, lane);
            }
        }
        SEAM(pb + 6);
    }
#undef IN
#undef SEAM
#undef GRID_BAR
}

extern "C" void kernel_launch(void* const* d_in, const int* in_sizes, int n_in, void* d_out, int out_size, void* d_ws, size_t ws_size, hipStream_t stream) {
    static int grid = 0;
    if (grid == 0) {
        if (n_in != 27 || ws_size < WS_END) { fprintf(stderr, "kernel_launch: expected 27 inputs and >= %zu bytes of workspace (got %d, %zu)\n", (size_t)WS_END, n_in, ws_size); grid = -1; return; }
        int dev = 0, cus = 0, per_cu = 0;
        if (hipGetDevice(&dev) != hipSuccess || hipDeviceGetAttribute(&cus, hipDeviceAttributeMultiprocessorCount, dev) != hipSuccess) { grid = -1; return; }
        if (hipFuncSetAttribute((const void*)mega_fwd, hipFuncAttributeMaxDynamicSharedMemorySize, LDS_BYTES) != hipSuccess) { fprintf(stderr, "kernel_launch: hipFuncSetAttribute failed\n"); grid = -1; return; }
        if (hipOccupancyMaxActiveBlocksPerMultiprocessor(&per_cu, (const void*)mega_fwd, NWAVES * 64, LDS_BYTES) != hipSuccess || per_cu < 1)
            fprintf(stderr, "kernel_launch: occupancy query reports %d workgroups per CU\n", per_cu);
        (void)hipGetLastError();
        grid = cus;
    }
    if (grid < 0) return;
    (void)hipMemsetAsync((char*)d_ws + WS_CTL, 0, CTL_ZERO_BYTES, stream);
    Args a{};
    for (int i = 0; i < 27; ++i) a.in[i] = (const float*)d_in[i];
    a.out = (float*)d_out; a.ws = (unsigned char*)d_ws;
#if MK_PER_PHASE
    for (int p = 0; p < N_PHASES; ++p) { a.ph_lo = p; a.ph_hi = p + 1; hipLaunchKernelGGL(mega_fwd, dim3(grid), dim3(NWAVES * 64), LDS_BYTES, stream, a); }
#else
    a.ph_lo = 0; a.ph_hi = N_PHASES;
    hipLaunchKernelGGL(mega_fwd, dim3(grid), dim3(NWAVES * 64), LDS_BYTES, stream, a);
#endif
    const hipError_t le = hipPeekAtLastError();
    if (le != hipSuccess) fprintf(stderr, "kernel_launch: launch failed: %s\n", hipGetErrorName(le));
}
```
